# Optimizing an MI355X kernel written in HIP

```python
import math
import jax, jax.numpy as jnp
from jax import lax
import numpy as np

D_MODEL = 4096
BATCH = 2
SEQ = 4096
DEPTH = 2

CHUNK = 64
HEAD_DIM = 128
EPS = 1e-6
SSM_WIDTH = 1024
SSM_GROUP = 16
SSM_GROUPS = SSM_WIDTH // SSM_GROUP
SSM_STATE = 64
CA_HEADS = 12
CA_WIDTH = CA_HEADS * HEAD_DIM
CA_LEFT_CHUNKS = 8
CA_BAND = (CA_LEFT_CHUNKS + 1) * CHUNK
REL_CLIP = 128
DA_HEADS = 6
DA_WIDTH = DA_HEADS * 2 * HEAD_DIM
Q_BLOCK = 128
N_BRANCH = 3
D_FF = 4 * D_MODEL
IN_WIDTH = SSM_WIDTH + 3 * CA_WIDTH + 3 * DA_WIDTH + N_BRANCH * D_MODEL

kernel_name = "hybrid_s5_chunkattn_diffattn_gated_block"


def rms_norm(x, gain):
    x32 = x.astype(jnp.float32)
    y = x32 * lax.rsqrt(jnp.mean(x32 * x32, axis=-1, keepdims=True) + EPS)
    return (y * gain.astype(jnp.float32)).astype(x.dtype)


def alibi_slopes(n_heads):
    return 2.0 ** (-8.0 * jnp.arange(1, n_heads + 1, dtype=jnp.float32) / n_heads)


def s5_mixer(u, a_re, a_im, log_dt, b_re, b_im, c_re, c_im, d_skip, w_glu, b_glu):
    bsz, seq, _ = u.shape
    f32 = jnp.float32
    lam = lax.complex(jnp.minimum(a_re.astype(f32), -1e-4), a_im.astype(f32))
    dt = jnp.exp(log_dt.astype(f32))[:, None]
    a_bar = jnp.exp(lam * dt)
    b = lax.complex(b_re.astype(f32), b_im.astype(f32))
    b_bar = ((a_bar - 1.0) / lam)[..., None] * b
    c = lax.complex(c_re.astype(f32), c_im.astype(f32))
    ug = u.astype(f32).reshape(bsz, seq, SSM_GROUPS, SSM_GROUP)
    bu = jnp.einsum('gph,bsgh->sbgp', b_bar, ug)
    a_seq = jnp.broadcast_to(a_bar, bu.shape)

    def combine(left, right):
        a_l, b_l = left
        a_r, b_r = right
        return a_r * a_l, a_r * b_l + b_r

    _, states = lax.associative_scan(combine, (a_seq, bu), axis=0)
    y = jnp.einsum('ghp,sbgp->bsgh', c, states).real.reshape(bsz, seq, SSM_WIDTH)
    y = y + d_skip.astype(f32) * u.astype(f32)
    z = jax.nn.gelu(y).astype(u.dtype)
    return z * jax.nn.sigmoid(z @ w_glu + b_glu)


def chunk_band_attention(q, k, v, q_gain, k_gain, rel_bias):
    bsz, seq, h, dh = q.shape
    f32 = jnp.float32
    nc = seq // CHUNK
    q = rms_norm(q, q_gain) * (dh ** -0.5)
    k = rms_norm(k, k_gain)
    pad = ((0, 0), (CA_LEFT_CHUNKS * CHUNK, 0), (0, 0), (0, 0))
    k_pad = jnp.pad(k, pad).reshape(bsz, nc + CA_LEFT_CHUNKS, CHUNK, h, dh)
    v_pad = jnp.pad(v, pad).reshape(bsz, nc + CA_LEFT_CHUNKS, CHUNK, h, dh)
    band_idx = jnp.arange(nc)[:, None] + jnp.arange(CA_LEFT_CHUNKS + 1)[None, :]
    k_band = k_pad[:, band_idx].reshape(bsz, nc, CA_BAND, h, dh)
    v_band = v_pad[:, band_idx].reshape(bsz, nc, CA_BAND, h, dh)
    qc = q.reshape(bsz, nc, CHUNK, h, dh)
    scores = jnp.einsum('bnqhd,bnkhd->bhnqk', qc, k_band).astype(f32)
    rel = CA_LEFT_CHUNKS * CHUNK + jnp.arange(CHUNK)[:, None] - jnp.arange(CA_BAND)[None, :]
    rel_idx = jnp.clip(rel, -REL_CLIP, REL_CLIP) + REL_CLIP
    bias = rel_bias.astype(f32)[:, rel_idx]
    key_pos = (jnp.arange(nc)[:, None] - CA_LEFT_CHUNKS) * CHUNK + jnp.arange(CA_BAND)[None, :]
    valid = key_pos >= 0
    scores = scores + bias[None, :, None]
    scores = jnp.where(valid[None, None, :, None, :], scores, -1e30)
    p = jax.nn.softmax(scores, axis=-1).astype(v.dtype)
    out = jnp.einsum('bhnqk,bnkhd->bnqhd', p, v_band)
    return out.reshape(bsz, seq, h * dh)


def diff_attention(q, k, v, q_gain, k_gain, lam_q1, lam_k1, lam_q2, lam_k2, subln_gain, lambda_init):
    bsz, seq, h, _, dh = q.shape
    f32 = jnp.float32
    q = rms_norm(q, q_gain) * (dh ** -0.5)
    k = rms_norm(k, k_gain)
    lam = (jnp.exp(jnp.sum(lam_q1.astype(f32) * lam_k1.astype(f32)))
           - jnp.exp(jnp.sum(lam_q2.astype(f32) * lam_k2.astype(f32))) + lambda_init)
    slopes = alibi_slopes(h)
    key_pos = jnp.arange(seq)
    nb = seq // Q_BLOCK
    q_blocks = q.reshape(bsz, nb, Q_BLOCK, h, 2, dh).transpose(1, 0, 2, 3, 4, 5)

    def block(args):
        qb, start = args
        q_pos = start + jnp.arange(Q_BLOCK)
        s = jnp.einsum('bqhcd,bkhcd->bhcqk', qb, k).astype(f32)
        dist = jnp.abs(q_pos[:, None] - key_pos[None, :]).astype(f32)
        s = s - slopes[None, :, None, None, None] * dist[None, None, None]
        allowed = (key_pos[None, :] // CHUNK) <= (q_pos[:, None] // CHUNK)
        s = jnp.where(allowed, s, -1e30)
        p = jax.nn.softmax(s, axis=-1)
        w = p[:, :, 0] - lam * p[:, :, 1]
        return jnp.einsum('bhqk,bkhe->bqhe', w.astype(v.dtype), v)

    out = lax.map(block, (q_blocks, jnp.arange(nb) * Q_BLOCK))
    out = out.transpose(1, 0, 2, 3, 4).reshape(bsz, seq, h, 2 * dh)
    out = rms_norm(out, subln_gain) * (1.0 - lambda_init)
    return out.reshape(bsz, seq, h * 2 * dh)


def setup_inputs(seed: int = 0) -> dict:
    key = jax.random.key(seed)
    ks = jax.random.split(key, 32)
    f32 = jnp.float32
    nrm = lambda k, shape, scale: jax.random.normal(k, shape, f32) * scale
    L, G, P = DEPTH, SSM_GROUPS, SSM_STATE
    return {
        "x": jax.random.normal(ks[0], (BATCH, SEQ, D_MODEL), f32),
        "norm_mix": 1.0 + nrm(ks[1], (L, D_MODEL), 0.02),
        "w_in": nrm(ks[2], (L, D_MODEL, IN_WIDTH), D_MODEL ** -0.5),
        "ssm_a_re": -0.5 + nrm(ks[3], (L, G, P), 0.01),
        "ssm_a_im": jnp.pi * jnp.arange(P, dtype=f32)[None, None, :] + nrm(ks[4], (L, G, P), 0.01),
        "ssm_log_dt": jax.random.uniform(ks[5], (L, G), f32, math.log(1e-3), math.log(1e-1)),
        "ssm_b_re": nrm(ks[6], (L, G, P, SSM_GROUP), (2 * SSM_GROUP) ** -0.5),
        "ssm_b_im": nrm(ks[7], (L, G, P, SSM_GROUP), (2 * SSM_GROUP) ** -0.5),
        "ssm_c_re": nrm(ks[8], (L, G, SSM_GROUP, P), (2 * P) ** -0.5),
        "ssm_c_im": nrm(ks[9], (L, G, SSM_GROUP, P), (2 * P) ** -0.5),
        "ssm_d": nrm(ks[10], (L, SSM_WIDTH), 1.0),
        "ssm_w_glu": nrm(ks[11], (L, SSM_WIDTH, SSM_WIDTH), SSM_WIDTH ** -0.5),
        "ssm_b_glu": nrm(ks[12], (L, SSM_WIDTH), 0.02),
        "ca_q_gain": 1.0 + nrm(ks[13], (L, HEAD_DIM), 0.02),
        "ca_k_gain": 1.0 + nrm(ks[14], (L, HEAD_DIM), 0.02),
        "ca_rel_bias": nrm(ks[15], (L, CA_HEADS, 2 * REL_CLIP + 1), 0.1),
        "da_q_gain": 1.0 + nrm(ks[16], (L, HEAD_DIM), 0.02),
        "da_k_gain": 1.0 + nrm(ks[17], (L, HEAD_DIM), 0.02),
        "da_lam_q1": nrm(ks[18], (L, HEAD_DIM), 0.1),
        "da_lam_k1": nrm(ks[19], (L, HEAD_DIM), 0.1),
        "da_lam_q2": nrm(ks[20], (L, HEAD_DIM), 0.1),
        "da_lam_k2": nrm(ks[21], (L, HEAD_DIM), 0.1),
        "da_subln_gain": 1.0 + nrm(ks[22], (L, 2 * HEAD_DIM), 0.02),
        "w_out_a": nrm(ks[23], (L, SSM_WIDTH, D_MODEL), SSM_WIDTH ** -0.5),
        "w_out_b": nrm(ks[24], (L, CA_WIDTH, D_MODEL), CA_WIDTH ** -0.5),
        "w_out_c": nrm(ks[25], (L, DA_WIDTH, D_MODEL), DA_WIDTH ** -0.5),
        "w_o": nrm(ks[26], (L, D_MODEL, D_MODEL), D_MODEL ** -0.5),
        "norm_mlp": 1.0 + nrm(ks[27], (L, D_MODEL), 0.02),
        "w_ff1": nrm(ks[28], (L, D_MODEL, D_FF), D_MODEL ** -0.5),
        "w_ff2": nrm(ks[29], (L, D_FF, D_MODEL), D_FF ** -0.5),
    }


def reference(x, norm_mix, w_in, ssm_a_re, ssm_a_im, ssm_log_dt, ssm_b_re, ssm_b_im, ssm_c_re, ssm_c_im,
              ssm_d, ssm_w_glu, ssm_b_glu, ca_q_gain, ca_k_gain, ca_rel_bias, da_q_gain, da_k_gain,
              da_lam_q1, da_lam_k1, da_lam_q2, da_lam_k2, da_subln_gain, w_out_a, w_out_b, w_out_c,
              w_o, norm_mlp, w_ff1, w_ff2):
    bsz, seq, _ = x.shape
    widths = [SSM_WIDTH, CA_WIDTH, CA_WIDTH, CA_WIDTH, DA_WIDTH, DA_WIDTH, DA_WIDTH]
    split_points = [int(v) for v in np.cumsum(widths)]
    for l in range(DEPTH):
        lambda_init = 0.8 - 0.6 * math.exp(-0.3 * l)
        h = rms_norm(x, norm_mix[l])
        proj = h @ w_in[l]
        u_a, q_b, k_b, v_b, q_c, k_c, v_c, gates = jnp.split(proj, split_points, axis=-1)
        y_a = s5_mixer(u_a, ssm_a_re[l], ssm_a_im[l], ssm_log_dt[l], ssm_b_re[l], ssm_b_im[l],
                       ssm_c_re[l], ssm_c_im[l], ssm_d[l], ssm_w_glu[l], ssm_b_glu[l])
        y_b = chunk_band_attention(q_b.reshape(bsz, seq, CA_HEADS, HEAD_DIM),
                                   k_b.reshape(bsz, seq, CA_HEADS, HEAD_DIM),
                                   v_b.reshape(bsz, seq, CA_HEADS, HEAD_DIM),
                                   ca_q_gain[l], ca_k_gain[l], ca_rel_bias[l])
        y_c = diff_attention(q_c.reshape(bsz, seq, DA_HEADS, 2, HEAD_DIM),
                             k_c.reshape(bsz, seq, DA_HEADS, 2, HEAD_DIM),
                             v_c.reshape(bsz, seq, DA_HEADS, 2 * HEAD_DIM),
                             da_q_gain[l], da_k_gain[l], da_lam_q1[l], da_lam_k1[l],
                             da_lam_q2[l], da_lam_k2[l], da_subln_gain[l], lambda_init)
        g = jax.nn.sigmoid(gates.reshape(bsz, seq, N_BRANCH, D_MODEL))
        merged = (g[:, :, 0] * (y_a @ w_out_a[l])
                  + g[:, :, 1] * (y_b @ w_out_b[l])
                  + g[:, :, 2] * (y_c @ w_out_c[l]))
        x = x + merged @ w_o[l]
        h = rms_norm(x, norm_mlp[l])
        x = x + jnp.square(jax.nn.relu(h @ w_ff1[l])) @ w_ff2[l]
    return x
```

```cpp
#define MK_N_LAUNCHES 17
#include <hip/hip_runtime.h>
#include <cstdio>
#include <cstdint>
namespace pg8 {
#define PG8_LAS __attribute__((address_space(3)))
typedef unsigned short bf16_t;
typedef short bf16x8 __attribute__((ext_vector_type(8)));
typedef float f32x4 __attribute__((ext_vector_type(4)));
typedef unsigned u32x4 __attribute__((ext_vector_type(4)));
constexpr int BM = 256, BK = 64, HALF = 128, HTB = HALF * BK * 2  , STAGE_BYTES = 8 * HTB, NXCD = 8, WGM = 8;

__host__ __device__ __forceinline__ int lds_byte(int r, int c) { const int st = (r >> 4) * 2 + (c >> 5), rr = r & 15, cc = c & 31, ob = rr * 64 + cc * 2; return st * 1024 + (ob ^ (((ob >> 9) & 1) << 5)); }
__host__ __device__ __forceinline__ void stage_rc(int b, int& R, int& C) { const int st = b / 1024, sb = b % 1024, swz = sb ^ (((sb >> 9) & 1) << 5); R = (st >> 1) * 16 + swz / 64; C = (st & 1) * 32 + (swz % 64) / 2; }
__host__ __device__ __forceinline__ int perm32(int rho) { const int n = rho >> 4, i = rho & 15; return 8 * (i >> 2) + 4 * n + (i & 3); }

struct Unit { int pm, pn; };
struct Gemm { const bf16_t* A; const bf16_t* Bt; int M, N, K; };

struct StaticOrder {
    int nM, nN, nwg, G, c;
    __host__ __device__ void init(int M, int N, int G_, int c_) { nM = M / BM; nN = N / BM; nwg = nM * nN; G = G_; c = c_; }
    __host__ __device__ bool next(int i, Unit& u) const {
        const long L = (long)i * G + c; if (L >= nwg) return false;
        int wgid = (int)L; { const int q = nwg / NXCD, r = nwg % NXCD, xcd = wgid % NXCD, off = wgid / NXCD; wgid = (xcd < r ? xcd * (q + 1) : r * (q + 1) + (xcd - r) * q) + off; }
        const int nig = WGM * nN, gid = wgid / nig, fm = gid * WGM, gsz = (nM - fm) < WGM ? (nM - fm) : WGM;
        u.pm = fm + ((wgid % nig) % gsz); u.pn = (wgid % nig) / gsz; return true;
    }
    __device__ __forceinline__ void a_ready(const Unit&) const {}
    __device__ __forceinline__ void done(const Unit&) const {}
};

__device__ __forceinline__ unsigned cvt_pk_bf16(float lo, float hi) { unsigned r; asm volatile("v_cvt_pk_bf16_f32 %0, %1, %2" : "=v"(r) : "v"(lo), "v"(hi)); return r; }
typedef float f32x2 __attribute__((ext_vector_type(2)));
__device__ __forceinline__ u32x4 pack8(f32x4 v0, f32x4 v1) { u32x4 w; w.x = cvt_pk_bf16(v0[0], v0[1]); w.y = cvt_pk_bf16(v0[2], v0[3]); w.z = cvt_pk_bf16(v1[0], v1[1]); w.w = cvt_pk_bf16(v1[2], v1[3]); return w; }
__device__ __forceinline__ void unpack8(u32x4 w, f32x4& v0, f32x4& v1) {
    v0[0] = __uint_as_float(w.x << 16); v0[1] = __uint_as_float(w.x & 0xffff0000u); v0[2] = __uint_as_float(w.y << 16); v0[3] = __uint_as_float(w.y & 0xffff0000u);
    v1[0] = __uint_as_float(w.z << 16); v1[1] = __uint_as_float(w.z & 0xffff0000u); v1[2] = __uint_as_float(w.w << 16); v1[3] = __uint_as_float(w.w & 0xffff0000u); }
__device__ __forceinline__ float sigm(float x) { return __builtin_amdgcn_rcpf(1.0f + __builtin_amdgcn_exp2f(-1.4426950408889634f * x)); }
__device__ __forceinline__ f32x4 sigm4(f32x4 v) { f32x4 o; o[0] = sigm(v[0]); o[1] = sigm(v[1]); o[2] = sigm(v[2]); o[3] = sigm(v[3]); return o; }

struct EpiIn {
    static constexpr bool PERM = true, AFTER_DRAIN = false;
    const float* ss; float* UA; bf16_t* QKV; bf16_t* GT;
    __device__ __forceinline__ void operator()(const f32x4 (&acc)[2][2][4][2], const Unit& u, int wr, int wc, int fr, int fq) const {
        const int row0 = u.pm * BM + wr * 64 + fr, colt = u.pn * BM, cin = wc * 32 + 8 * fq;
#pragma unroll
        for (int ai = 0; ai < 2; ++ai)
#pragma unroll
            for (int m = 0; m < 4; ++m) { const int row = row0 + ai * HALF + m * 16; const float r = rsqrtf(ss[row] * (1.0f / 4096.0f) + 1e-6f);
#pragma unroll
                for (int bj = 0; bj < 2; ++bj) { f32x4 v0 = acc[ai][bj][m][0] * r, v1 = acc[ai][bj][m][1] * r; const int c = cin + bj * HALF;
                    if (colt < 1024) { float* p = UA + (size_t)row * 1024 + colt + c; *(f32x4*)p = v0; *(f32x4*)(p + 4) = v1; }
                    else if (colt < 10240) { *(u32x4*)(QKV + (size_t)row * 9216 + (colt - 1024) + c) = pack8(v0, v1); }
                    else { *(u32x4*)(GT + (size_t)row * 12288 + (colt - 10240) + c) = pack8(sigm4(v0), sigm4(v1)); } }
                asm volatile("" ::: "memory"); }
    }
};
struct EpiGlu {
    static constexpr bool PERM = true, AFTER_DRAIN = false;
    const bf16_t* Z; const float* bias; bf16_t* YA;
    __device__ __forceinline__ void operator()(const f32x4 (&acc)[2][2][4][2], const Unit& u, int wr, int wc, int fr, int fq) const {
        const int row0 = u.pm * BM + wr * 64 + fr, col0 = u.pn * BM + wc * 32 + 8 * fq;
        f32x4 bv[2][2];
#pragma unroll
        for (int bj = 0; bj < 2; ++bj)
#pragma unroll
            for (int n = 0; n < 2; ++n) bv[bj][n] = *(const f32x4*)(bias + col0 + bj * HALF + 4 * n);
#pragma unroll
        for (int ai = 0; ai < 2; ++ai)
#pragma unroll
            for (int m = 0; m < 4; ++m) { const size_t off = (size_t)(row0 + ai * HALF + m * 16) * 1024 + col0;
#pragma unroll
                for (int bj = 0; bj < 2; ++bj) { f32x4 z0, z1; unpack8(*(const u32x4*)(Z + off + bj * HALF), z0, z1);
                    const f32x4 v0 = z0 * sigm4(acc[ai][bj][m][0] + bv[bj][0]), v1 = z1 * sigm4(acc[ai][bj][m][1] + bv[bj][1]);
                    *(u32x4*)(YA + off + bj * HALF) = pack8(v0, v1); }
                asm volatile("" ::: "memory"); }
    }
};
template <int MODE> struct EpiMerge {
    static constexpr bool PERM = true, AFTER_DRAIN = false;
    const bf16_t* GT; int goff; float* MF; bf16_t* MB;
    __device__ __forceinline__ void operator()(const f32x4 (&acc)[2][2][4][2], const Unit& u, int wr, int wc, int fr, int fq) const {
        const int row0 = u.pm * BM + wr * 64 + fr, col0 = u.pn * BM + wc * 32 + 8 * fq;
#pragma unroll
        for (int ai = 0; ai < 2; ++ai)
#pragma unroll
            for (int m = 0; m < 4; ++m) { const int row = row0 + ai * HALF + m * 16; const size_t off = (size_t)row * 4096 + col0;
#pragma unroll
                for (int bj = 0; bj < 2; ++bj) { f32x4 g0, g1; unpack8(*(const u32x4*)(GT + (size_t)row * 12288 + goff + col0 + bj * HALF), g0, g1);
                    f32x4 v0 = g0 * acc[ai][bj][m][0], v1 = g1 * acc[ai][bj][m][1]; float* p = MF + off + bj * HALF;
                    if (MODE >= 1) { v0 += *(const f32x4*)p; v1 += *(const f32x4*)(p + 4); }
                    if (MODE <= 1) { *(f32x4*)p = v0; *(f32x4*)(p + 4) = v1; }
                    else { *(u32x4*)(MB + off + bj * HALF) = pack8(v0, v1); } }
                asm volatile("" ::: "memory"); }
    }
};
struct EpiRes {
    static constexpr bool PERM = true, AFTER_DRAIN = false;
    const float* base; float* outf; bf16_t* XB; float* ss;
    __device__ __forceinline__ void operator()(const f32x4 (&acc)[2][2][4][2], const Unit& u, int wr, int wc, int fr, int fq) const {
        const int row0 = u.pm * BM + wr * 64 + fr, col0 = u.pn * BM + wc * 32 + 8 * fq;
#pragma unroll
        for (int ai = 0; ai < 2; ++ai)
#pragma unroll
            for (int m = 0; m < 4; ++m) { const int row = row0 + ai * HALF + m * 16; const size_t off = (size_t)row * 4096 + col0; float q = 0.f;
#pragma unroll
                for (int bj = 0; bj < 2; ++bj) { const float* bp = base + off + bj * HALF; const f32x4 v0 = acc[ai][bj][m][0] + *(const f32x4*)bp, v1 = acc[ai][bj][m][1] + *(const f32x4*)(bp + 4);
                    float* op = outf + off + bj * HALF; *(f32x4*)op = v0; *(f32x4*)(op + 4) = v1;
                    if (XB) *(u32x4*)(XB + off + bj * HALF) = pack8(v0, v1);
                    q += (v0[0] * v0[0] + v0[1] * v0[1]) + (v0[2] * v0[2] + v0[3] * v0[3]) + (v1[0] * v1[0] + v1[1] * v1[1]) + (v1[2] * v1[2] + v1[3] * v1[3]); }
                if (ss) { q += __shfl_xor(q, 16); q += __shfl_xor(q, 32); if (fq == 0) atomicAdd(ss + row, q); }
                asm volatile("" ::: "memory"); }
    }
};
struct EpiFf1 {
    static constexpr bool PERM = true, AFTER_DRAIN = false;
    const float* ss; bf16_t* H;
    __device__ __forceinline__ void operator()(const f32x4 (&acc)[2][2][4][2], const Unit& u, int wr, int wc, int fr, int fq) const {
        const int row0 = u.pm * BM + wr * 64 + fr, col0 = u.pn * BM + wc * 32 + 8 * fq;
#pragma unroll
        for (int ai = 0; ai < 2; ++ai)
#pragma unroll
            for (int m = 0; m < 4; ++m) { const int row = row0 + ai * HALF + m * 16; const float r = rsqrtf(ss[row] * (1.0f / 4096.0f) + 1e-6f);
#pragma unroll
                for (int bj = 0; bj < 2; ++bj) { f32x4 v0 = acc[ai][bj][m][0] * r, v1 = acc[ai][bj][m][1] * r;
#pragma unroll
                    for (int j = 0; j < 4; ++j) { const float a = fmaxf(v0[j], 0.f), b = fmaxf(v1[j], 0.f); v0[j] = a * a; v1[j] = b * b; }
                    *(u32x4*)(H + (size_t)row * 16384 + col0 + bj * HALF) = pack8(v0, v1); }
                asm volatile("" ::: "memory"); }
    }
};
template <class Epi, class Sched, bool ALIGN_EPI = false, bool SP2 = false>
__device__ __forceinline__ void gemm_phase(PG8_LAS unsigned char* lds, const Gemm g, const Sched& S, const Epi& E) {
    int tid_ = threadIdx.x; asm volatile("" : "+v"(tid_));
    const int tid = tid_, wid = __builtin_amdgcn_readfirstlane(tid >> 6), lane = tid & 63, wr = wid >> 2, wc = wid & 3, fr = lane & 15, fq = lane >> 4;
    const int K = g.K, nt = K / BK;
    unsigned voffA[2], voffB[2];
#pragma unroll
    for (int i = 0; i < 2; ++i) { int R, C; stage_rc(tid * 16 + i * 8192, R, C); const int Rb = Epi::PERM ? ((R & ~31) + perm32(R & 31)) : R;
        voffA[i] = (unsigned)(R * K + C) * 2u; voffB[i] = (unsigned)(Rb * K + C) * 2u; }
    const size_t kstep = (size_t)(BK * 2);
    const size_t hstep = (size_t)HALF * K * 2;
    const size_t tstep = 2 * hstep;
    const unsigned ldsw = (unsigned)wid * 1024u;
    const int aoff = lds_byte(wr * 64 + fr, fq * 8), boff = lds_byte(wc * 32 + fr, fq * 8);
#define PG8_SA(b, h) (((b) * 2 + (h)) * HTB)
#define PG8_SB(b, h) ((4 + (b) * 2 + (h)) * HTB)
#define PG8_STAGE(bufoff, gbase, voff) do { _Pragma("unroll") for (int _i = 0; _i < 2; ++_i) \
        __builtin_amdgcn_global_load_lds((const unsigned*)((const char*)(gbase) + (voff)[_i]), (PG8_LAS unsigned*)(lds + (bufoff) + ldsw + _i * 8192), 16, 0, 0); } while (0)
#define PG8_LDA(dst, b, h) do { _Pragma("unroll") for (int m = 0; m < 4; ++m) _Pragma("unroll") for (int k = 0; k < 2; ++k) dst[m][k] = *(const PG8_LAS bf16x8*)(lds + PG8_SA(b, h) + aoff + m * 2048 + k * 1024); } while (0)
#define PG8_LDB(dst, b, h) do { _Pragma("unroll") for (int n = 0; n < 2; ++n) _Pragma("unroll") for (int k = 0; k < 2; ++k) dst[n][k] = *(const PG8_LAS bf16x8*)(lds + PG8_SB(b, h) + boff + n * 2048 + k * 1024); } while (0)
#define PG8_MMA(ai, bj, At, Bt) do { __builtin_amdgcn_s_setprio(1); _Pragma("unroll") for (int m = 0; m < 4; ++m) _Pragma("unroll") for (int n = 0; n < 2; ++n) _Pragma("unroll") for (int k = 0; k < 2; ++k) \
        acc[ai][bj][m][n] = __builtin_amdgcn_mfma_f32_16x16x32_bf16(Bt[n][k], At[m][k], acc[ai][bj][m][n], 0, 0, 0); __builtin_amdgcn_s_setprio(0); } while (0)
#define PG8_WAIT_V(n) asm volatile("s_waitcnt vmcnt(" #n ")" ::: "memory")
#define PG8_WAIT_L(n) asm volatile("s_waitcnt lgkmcnt(" #n ")" ::: "memory")
#define PG8_BAR __builtin_amdgcn_s_barrier()
#define PG8_SCHED __builtin_amdgcn_sched_barrier(0)
    Unit cur, nxt; int ui = 0;
    if (!S.next(0, cur)) return;
    f32x4 acc[2][2][4][2];
#pragma unroll
    for (int a = 0; a < 2; ++a)
#pragma unroll
        for (int b = 0; b < 2; ++b)
#pragma unroll
            for (int m = 0; m < 4; ++m)
#pragma unroll
                for (int n = 0; n < 2; ++n) acc[a][b][m][n] = (f32x4){0.f, 0.f, 0.f, 0.f};
    bf16x8 At[4][2], B0[2][2], B1[2][2];
    const char* cA = (const char*)g.A + (size_t)cur.pm * tstep; const char* cB = (const char*)g.Bt + (size_t)cur.pn * tstep;
    S.a_ready(cur);
    if constexpr (SP2) {
        PG8_STAGE(PG8_SB(0, 0), cB, voffB); PG8_STAGE(PG8_SB(0, 1), cB + hstep, voffB); PG8_STAGE(PG8_SA(0, 0), cA, voffA); PG8_STAGE(PG8_SA(0, 1), cA + hstep, voffA);
        if (wr == 1) PG8_BAR;
        PG8_WAIT_V(2); PG8_BAR;
        PG8_STAGE(PG8_SB(1, 0), cB + kstep, voffB); PG8_STAGE(PG8_SA(1, 0), cA + kstep, voffA); PG8_STAGE(PG8_SB(1, 1), cB + hstep + kstep, voffB);
        PG8_WAIT_V(6); PG8_BAR;
    } else {
        PG8_STAGE(PG8_SB(0, 0), cB, voffB); PG8_STAGE(PG8_SA(0, 0), cA, voffA); PG8_STAGE(PG8_SB(0, 1), cB + hstep, voffB); PG8_STAGE(PG8_SA(0, 1), cA + hstep, voffA);
        if (wr == 1) PG8_BAR;
        PG8_WAIT_V(4); PG8_BAR;
        PG8_STAGE(PG8_SB(1, 0), cB + kstep, voffB); PG8_STAGE(PG8_SA(1, 0), cA + kstep, voffA); PG8_STAGE(PG8_SB(1, 1), cB + hstep + kstep, voffB);
        PG8_WAIT_V(6); PG8_BAR;
    }
    for (;;) {
        const bool has_next = S.next(ui + 1, nxt);
        const char* nA = has_next ? (const char*)g.A + (size_t)nxt.pm * tstep : cA; const char* nB = has_next ? (const char*)g.Bt + (size_t)nxt.pn * tstep : cB;
        for (int t = 0; t < nt; t += 2) {
            const bool last = (t == nt - 2);
            const char* a1 = cA + (size_t)(t + 1) * kstep;
            const char* a2 = last ? nA : cA + (size_t)(t + 2) * kstep; const char* b2 = last ? nB : cB + (size_t)(t + 2) * kstep;
            const char* a3 = a2 + kstep; const char* b3 = b2 + kstep;
            if (last && has_next) S.a_ready(nxt);
            if constexpr (SP2) {
            PG8_LDB(B0, 0, 0); PG8_LDB(B1, 0, 1); PG8_SCHED; PG8_LDA(At, 0, 0); PG8_STAGE(PG8_SA(1, 1), a1 + hstep, voffA);
            PG8_WAIT_V(8); PG8_WAIT_L(0); PG8_BAR; PG8_MMA(0, 0, At, B0); PG8_MMA(0, 1, At, B1); PG8_BAR; PG8_SCHED;
            PG8_LDA(At, 0, 1); PG8_STAGE(PG8_SB(0, 0), b2, voffB); PG8_STAGE(PG8_SB(0, 1), b2 + hstep, voffB); PG8_STAGE(PG8_SA(0, 0), a2, voffA);
            PG8_WAIT_V(8); PG8_WAIT_L(0); PG8_BAR; PG8_MMA(1, 0, At, B0); PG8_MMA(1, 1, At, B1); PG8_BAR; PG8_SCHED;
            PG8_LDB(B0, 1, 0); PG8_LDB(B1, 1, 1); PG8_SCHED; PG8_LDA(At, 1, 0); PG8_STAGE(PG8_SA(0, 1), a2 + hstep, voffA);
            PG8_WAIT_V(8); PG8_WAIT_L(0); PG8_BAR; PG8_MMA(0, 0, At, B0); PG8_MMA(0, 1, At, B1); PG8_BAR; PG8_SCHED;
            PG8_LDA(At, 1, 1); PG8_STAGE(PG8_SB(1, 0), b3, voffB); PG8_STAGE(PG8_SB(1, 1), b3 + hstep, voffB); PG8_STAGE(PG8_SA(1, 0), a3, voffA);
            PG8_WAIT_V(8); PG8_WAIT_L(0); PG8_BAR; PG8_MMA(1, 0, At, B0); PG8_MMA(1, 1, At, B1); PG8_BAR; PG8_SCHED;
            } else {
            PG8_LDB(B0, 0, 0); PG8_SCHED; PG8_LDA(At, 0, 0); PG8_STAGE(PG8_SA(1, 1), a1 + hstep, voffA);
            PG8_WAIT_L(8); PG8_BAR; PG8_WAIT_L(0); PG8_MMA(0, 0, At, B0); PG8_BAR; PG8_SCHED;
            PG8_LDB(B1, 0, 1); PG8_STAGE(PG8_SB(0, 0), b2, voffB);
            PG8_BAR; PG8_WAIT_L(0); PG8_MMA(0, 1, At, B1); PG8_BAR;
            PG8_LDA(At, 0, 1); PG8_STAGE(PG8_SA(0, 0), a2, voffA);
            PG8_BAR; PG8_WAIT_L(0); PG8_MMA(1, 0, At, B0); PG8_BAR; PG8_SCHED;
            PG8_STAGE(PG8_SB(0, 1), b2 + hstep, voffB);
            PG8_WAIT_V(6); PG8_BAR; PG8_MMA(1, 1, At, B1); PG8_BAR;
            PG8_LDB(B0, 1, 0); PG8_SCHED; PG8_LDA(At, 1, 0); PG8_STAGE(PG8_SA(0, 1), a2 + hstep, voffA);
            PG8_WAIT_L(8); PG8_BAR; PG8_WAIT_L(0); PG8_MMA(0, 0, At, B0); PG8_BAR; PG8_SCHED;
            PG8_LDB(B1, 1, 1); PG8_STAGE(PG8_SB(1, 0), b3, voffB);
            PG8_BAR; PG8_WAIT_L(0); PG8_MMA(0, 1, At, B1); PG8_BAR;
            PG8_LDA(At, 1, 1); PG8_STAGE(PG8_SA(1, 0), a3, voffA);
            PG8_BAR; PG8_WAIT_L(0); PG8_MMA(1, 0, At, B0); PG8_BAR; PG8_SCHED;
            PG8_STAGE(PG8_SB(1, 1), b3 + hstep, voffB);
            PG8_WAIT_V(6); PG8_BAR; PG8_MMA(1, 1, At, B1); PG8_BAR;
            }
        }
        if constexpr (ALIGN_EPI) { if (wr == 0) PG8_BAR; }
        if constexpr (!Epi::AFTER_DRAIN) { E(acc, cur, wr, wc, fr, fq); S.done(cur); }
        if (!has_next) break;
#pragma unroll
        for (int a = 0; a < 2; ++a)
#pragma unroll
            for (int b = 0; b < 2; ++b)
#pragma unroll
                for (int m = 0; m < 4; ++m)
#pragma unroll
                    for (int n = 0; n < 2; ++n) acc[a][b][m][n] = (f32x4){0.f, 0.f, 0.f, 0.f};
        cur = nxt; cA = nA; cB = nB; ++ui;
        if constexpr (ALIGN_EPI) { if (wr == 1) PG8_BAR; }
    }
    PG8_WAIT_V(0);
    if constexpr (!ALIGN_EPI) { if (wr == 0) PG8_BAR; }
    PG8_BAR;
    if constexpr (Epi::AFTER_DRAIN) { E.fused(acc, cur, wr, wc, fr, fq, lds, wid, lane); S.done(cur); }
#undef PG8_SA
#undef PG8_SB
#undef PG8_STAGE
#undef PG8_LDA
#undef PG8_LDB
#undef PG8_MMA
#undef PG8_WAIT_V
#undef PG8_WAIT_L
#undef PG8_BAR
#undef PG8_SCHED
}
}
#define GAS __attribute__((address_space(1)))
#define LAS __attribute__((address_space(3)))
typedef unsigned short bf16;
typedef unsigned v4u __attribute__((ext_vector_type(4)));
typedef float f32x4 __attribute__((ext_vector_type(4)));
typedef short bf16x8 __attribute__((ext_vector_type(8)));
typedef GAS unsigned gu32;
typedef GAS unsigned long long gu64;
#define RLX_AGENT __ATOMIC_RELAXED, __HIP_MEMORY_SCOPE_AGENT
#define LDS_WAIT() asm volatile("s_waitcnt lgkmcnt(0)" ::: "memory")
#define VM_WAIT() asm volatile("s_waitcnt vmcnt(0)" ::: "memory")
__device__ __forceinline__ unsigned long long rt() { return __builtin_amdgcn_s_memrealtime(); }
__device__ __forceinline__ unsigned f2bf(float f) { unsigned u = __builtin_bit_cast(unsigned, f); return (u + 0x7fffu + ((u >> 16) & 1u)) >> 16; }
__device__ __forceinline__ unsigned pk2(float lo, float hi) { return f2bf(lo) | (f2bf(hi) << 16); }

#define XB_TMO      128
#define XB_XCNT(j)  (256  + 64 * (j))
#define XB_XSUB(j)  (1280 + 64 * (j))
#define XB_XGEN(j)  (2304 + 64 * (j))
#define XB_TOP      3328
#define XB_TOPGEN   3392
#define XCD_BAR_WORDS 3456
#define XB_SPIN_CAP (1u << 18)

__device__ __forceinline__ unsigned xb_ld(unsigned* p)              { return __hip_atomic_load(p, __ATOMIC_RELAXED, __HIP_MEMORY_SCOPE_AGENT); }
__device__ __forceinline__ unsigned xb_add(unsigned* p, unsigned v) { return __hip_atomic_fetch_add(p, v, __ATOMIC_RELAXED, __HIP_MEMORY_SCOPE_AGENT); }
__device__ __forceinline__ unsigned xb_xcc_id() { return (unsigned)__builtin_amdgcn_s_getreg((3 << 11) | 20) & 0xFu; }
#define XB_SPIN(cond, bar) do { unsigned _sp = 0; while (cond) { __builtin_amdgcn_s_sleep(1); \
    if ((++_sp & 255u) == 0u) { if (xb_ld(&(bar)[XB_TMO])) break; if (_sp > XB_SPIN_CAP) { atomicAdd(&(bar)[XB_TMO], 1u); break; } } } } while (0)

struct XcdBarrier {
    unsigned* bar; unsigned x;
    volatile LAS unsigned* st;
};

__device__ __forceinline__ XcdBarrier xcd_barrier_post(unsigned* bar, volatile LAS unsigned* st) {
    XcdBarrier b; b.bar = bar; b.x = xb_xcc_id(); b.st = st;
    if (threadIdx.x == 0) (void)xb_add(&bar[XB_XCNT(b.x)], 1u);
    return b;
}
__device__ __forceinline__ void xcd_barrier_complete(unsigned* bar, unsigned x, unsigned& nloc, unsigned& nx) {
    const unsigned G = gridDim.x * gridDim.y * gridDim.z;
    unsigned sum, cnt, mine, sp = 0u;
    for (;;) {
        sum = 0u; cnt = 0u; mine = 0u;
#pragma unroll
        for (unsigned j = 0; j < 16; ++j) { const unsigned c = xb_ld(&bar[XB_XCNT(j)]); sum += c; cnt += (c > 0u) ? 1u : 0u; mine = (j == x) ? c : mine; }
        if (sum == G) break;
        __builtin_amdgcn_s_sleep(1);
        if ((++sp & 255u) == 0u) { if (xb_ld(&bar[XB_TMO])) break; if (sp > XB_SPIN_CAP) { atomicAdd(&bar[XB_TMO], 1u); break; } }
    }
    nloc = mine > 0u ? mine : 1u; nx = cnt > 0u ? cnt : 1u;
}

__device__ __forceinline__ void xcd_barrier(const XcdBarrier& b) {
    asm volatile("s_waitcnt vmcnt(0)" ::: "memory");
    __syncthreads();
    if (threadIdx.x == 0) {
        unsigned* bar = b.bar;
        __builtin_amdgcn_s_waitcnt(0);
        unsigned nloc = b.st[0], nx = b.st[1];
        if (nloc == 0u) { xcd_barrier_complete(bar, b.x, nloc, nx); b.st[0] = nloc; b.st[1] = nx; }
        const unsigned old = xb_add(&bar[XB_XSUB(b.x)], 1u);
        const unsigned gen = old / nloc;
        if (old + 1u == (gen + 1u) * nloc) {
            __builtin_amdgcn_fence(__ATOMIC_RELEASE, "agent");
            asm volatile("s_waitcnt vmcnt(0)" ::: "memory");
            const unsigned og = xb_add(&bar[XB_TOP], 1u);
            const unsigned tg = og / nx;
            if (og + 1u == (tg + 1u) * nx) xb_add(&bar[XB_TOPGEN], 1u);
            else XB_SPIN(xb_ld(&bar[XB_TOPGEN]) == tg, bar);
            __builtin_amdgcn_fence(__ATOMIC_ACQUIRE, "agent");
            xb_add(&bar[XB_XGEN(b.x)], 1u);
            asm volatile("s_waitcnt vmcnt(0)" ::: "memory");
        } else {
            XB_SPIN(xb_ld(&bar[XB_XGEN(b.x)]) == gen, bar);
            __builtin_amdgcn_fence(__ATOMIC_ACQUIRE, "agent");
            asm volatile("s_waitcnt vmcnt(0)" ::: "memory");
        }
    }
    __syncthreads();
}

constexpr int NWAVES = 8;
constexpr int NB = 2, SEQ = 4096, DM = 4096, M = NB * SEQ, NL = 2, INW = 22528, DFF = 16384;
constexpr int SSMW = 1024, NGRP = 64, NST = 64, CAW = 1536, DAW = 1536, QKVW = 9216, GTW = 12288;
constexpr int CA_H = 12, DA_H = 6, HD = 128;
constexpr float EPS = 1e-6f, LOG2E = 1.4426950408889634f, QSCALE = 0.08838834764831845f * 1.4426950408889634f;
#ifndef MK_N_LAUNCHES
#define MK_N_LAUNCHES 1
#endif
constexpr int N_PHASES = 1 + 8 * NL;
constexpr int N_LAUNCHES = MK_N_LAUNCHES;
static_assert(N_LAUNCHES == 1 || N_LAUNCHES == N_PHASES, "MK_N_LAUNCHES is 1 or 17");

constexpr size_t MiB = 1u << 20;
constexpr size_t WS_CTL = 0, CTL_ZERO_BYTES = 1 * MiB;
constexpr size_t WS_TAB = 1 * MiB, WS_SE = 5 * MiB;
constexpr size_t WS_WT = 16 * MiB, WT_IN = 0, WT_GLU = 176 * MiB, WT_OA = 178 * MiB, WT_OB = 186 * MiB, WT_OC = 198 * MiB, WT_O = 210 * MiB, WT_F1 = 242 * MiB, WT_F2 = 370 * MiB, WT_LAYER = 498 * MiB;
constexpr size_t WS_XB = WS_WT + NL * WT_LAYER;
constexpr size_t WS_UA = WS_XB + 64 * MiB, WS_QKV = WS_UA + 32 * MiB, WS_GT = WS_QKV + 144 * MiB, WS_H = WS_QKV  ;
constexpr size_t WS_Z = WS_GT + 192 * MiB, WS_YA = WS_Z + 16 * MiB, WS_YB = WS_YA + 16 * MiB, WS_YC = WS_YB + 24 * MiB, WS_MF = WS_YC + 24 * MiB, WS_MB = WS_MF + 128 * MiB;
constexpr size_t WS_X1 = WS_MB + 64 * MiB, WS_END = WS_X1 + 128 * MiB;
static_assert((size_t)INW * DM * 2 == 176 * MiB && (size_t)M * QKVW * 2 == 144 * MiB && (size_t)M * GTW * 2 == 192 * MiB && (size_t)M * DFF * 2 <= 336 * MiB, "ws map");
constexpr int TAB_A = 0, TAB_AL = 16384, TAB_LAM = 32768, TAB_B = 65536;
constexpr int CW_TMO = 0, CW_CODE = 1, CW_BAR = 4096, CW_Q = 8192  , CW_SS = 16384  ;
static_assert((CW_SS + 4 * M) * 4 <= (int)CTL_ZERO_BYTES, "ctl");

constexpr int RING_OFF = 0, RING_BYTES = 131072;
constexpr int LDSCTL_OFF = RING_BYTES, MISC_OFF = LDSCTL_OFF + 320;
constexpr int LDS_BYTES = 147456;


typedef unsigned v2u __attribute__((ext_vector_type(2)));
struct Frame {
    LAS unsigned char* lds;
    volatile LAS unsigned* MISC;
    gu32* ctl;
    int tid, lane, wave, G;
    const float* const* in;
    unsigned char* ws;
};
__device__ __forceinline__ float wave_sum(float v) {
#pragma unroll
    for (int o = 1; o < 64; o <<= 1) v += __shfl_xor(v, o);
    return v;
}
__device__ __forceinline__ float wave_max(float v) {
#pragma unroll
    for (int o = 1; o < 64; o <<= 1) v = fmaxf(v, __shfl_xor(v, o));
    return v;
}
__device__ __forceinline__ unsigned cvtpk(float lo, float hi) { unsigned r; asm volatile("v_cvt_pk_bf16_f32 %0, %1, %2" : "=v"(r) : "v"(lo), "v"(hi)); return r; }
__device__ __forceinline__ float bflo(unsigned w) { return __uint_as_float(w << 16); }
__device__ __forceinline__ float bfhi(unsigned w) { return __uint_as_float(w & 0xffff0000u); }

__device__ __forceinline__ double d_exp(double x) {
    const double k = __builtin_rint(x * 1.4426950408889634); const double r = __builtin_fma(-k, 0.6931471805599453, x) - k * 2.3190468138462996e-17;
    double s = 1.0;
#pragma unroll
    for (int i = 16; i >= 1; --i) s = 1.0 + s * r * (1.0 / (double)i);
    return s * __longlong_as_double((long long)(1023 + (int)k) << 52);
}
__device__ __forceinline__ void d_sincos(double x, double& s, double& c) {
    const double n = __builtin_rint(x * 0.6366197723675814);
    double r = __builtin_fma(-n, 1.5707963267948966, x); r = __builtin_fma(-n, 6.123233995736766e-17, r);
    const double r2 = r * r;
    double sp = -1.0 / 1307674368000.0; sp = sp * r2 + 1.0 / 6227020800.0; sp = sp * r2 - 1.0 / 39916800.0; sp = sp * r2 + 1.0 / 362880.0; sp = sp * r2 - 1.0 / 5040.0; sp = sp * r2 + 1.0 / 120.0; sp = sp * r2 - 1.0 / 6.0; sp = sp * r2 + 1.0; sp *= r;
    double cp = 1.0 / 20922789888000.0; cp = cp * r2 - 1.0 / 87178291200.0; cp = cp * r2 + 1.0 / 479001600.0; cp = cp * r2 - 1.0 / 3628800.0; cp = cp * r2 + 1.0 / 40320.0; cp = cp * r2 - 1.0 / 720.0; cp = cp * r2 + 1.0 / 24.0; cp = cp * r2 - 0.5; cp = cp * r2 + 1.0;
    const int q = ((int)n) & 3;
    s = (q == 0) ? sp : (q == 1) ? cp : (q == 2) ? -sp : -cp;
    c = (q == 0) ? cp : (q == 1) ? -sp : (q == 2) ? -cp : sp;
}

__device__ __forceinline__ void tr_item(const float* W, int K, int N, const float* gain, bf16* WT, LAS unsigned* scr, int item, int lane) {
    const int nblk = N >> 6, kb = item / nblk, nb = item - kb * nblk, k0 = kb * 64, n0 = nb * 64;
    const int r = lane >> 4, c4 = lane & 15;
    f32x4 v[16];
#pragma unroll
    for (int i = 0; i < 16; ++i) { const int k = k0 + 8 * (i >> 1) + 2 * r + (i & 1); v[i] = *(const GAS f32x4*)(W + (size_t)k * N + n0 + 4 * c4); }
    if (gain) {
#pragma unroll
        for (int i = 0; i < 16; ++i) { const int k = k0 + 8 * (i >> 1) + 2 * r + (i & 1); v[i] = v[i] * gain[k]; }
    }
#pragma unroll
    for (int a = 0; a < 8; ++a)
#pragma unroll
        for (int j = 0; j < 4; ++j) scr[(4 * c4 + j) * 32 + 4 * (a ^ (c4 & 7)) + r] = cvtpk(v[2 * a][j], v[2 * a + 1][j]);
    LDS_WAIT(); asm volatile("" ::: "memory");
#pragma unroll
    for (int jj = 0; jj < 8; ++jj) { const int idx = lane + 64 * jj, n = idx >> 3, c = idx & 7;
        const v4u o = *(const LAS v4u*)(scr + n * 32 + 4 * (c ^ ((n >> 2) & 7)));
        *(GAS v4u*)(WT + (size_t)(n0 + n) * K + k0 + 8 * c) = o; }
    LDS_WAIT(); asm volatile("" ::: "memory");
}
__device__ __forceinline__ void tr_matrix(const Frame& F, const float* W, int K, int N, const float* gain, bf16* WT) {
    LAS unsigned* scr = (LAS unsigned*)(F.lds + RING_OFF + F.wave * 8192);
    const int gw = blockIdx.x * NWAVES + F.wave, NGW = F.G * NWAVES, nitems = (K >> 6) * (N >> 6);
    for (int it = gw; it < nitems; it += NGW) tr_item(W, K, N, gain, WT, scr, it, F.lane);
}

struct Args { const float* in[30]; float* out; unsigned char* ws; int ph_lo, ph_hi, li, pad; };
enum { I_X = 0, I_NORM_MIX, I_W_IN, I_A_RE, I_A_IM, I_LOG_DT, I_B_RE, I_B_IM, I_C_RE, I_C_IM, I_SSM_D, I_W_GLU, I_B_GLU, I_CA_QG, I_CA_KG, I_CA_BIAS, I_DA_QG, I_DA_KG,
       I_LQ1, I_LK1, I_LQ2, I_LK2, I_SUBLN, I_W_OA, I_W_OB, I_W_OC, I_W_O, I_NORM_MLP, I_W_FF1, I_W_FF2 };
__device__ __forceinline__ float lambda_init_of(int l) { return l == 0 ? 0.2f : 0.35550906759096926f; }

__device__ __forceinline__ void p0_prologue(const Frame& F, const Args& A) {
    unsigned char* ws = A.ws;
    for (int l = 0; l < NL; ++l) {
        unsigned char* wl = ws + WS_WT + (size_t)l * WT_LAYER;
        tr_matrix(F, A.in[I_W_IN] + (size_t)l * DM * INW, DM, INW, A.in[I_NORM_MIX] + l * DM, (bf16*)(wl + WT_IN));
        tr_matrix(F, A.in[I_W_GLU] + (size_t)l * SSMW * SSMW, SSMW, SSMW, nullptr, (bf16*)(wl + WT_GLU));
        tr_matrix(F, A.in[I_W_OA] + (size_t)l * SSMW * DM, SSMW, DM, nullptr, (bf16*)(wl + WT_OA));
        tr_matrix(F, A.in[I_W_OB] + (size_t)l * CAW * DM, CAW, DM, nullptr, (bf16*)(wl + WT_OB));
        tr_matrix(F, A.in[I_W_OC] + (size_t)l * DAW * DM, DAW, DM, nullptr, (bf16*)(wl + WT_OC));
        tr_matrix(F, A.in[I_W_O] + (size_t)l * DM * DM, DM, DM, nullptr, (bf16*)(wl + WT_O));
        tr_matrix(F, A.in[I_W_FF1] + (size_t)l * DM * DFF, DM, DFF, A.in[I_NORM_MLP] + l * DM, (bf16*)(wl + WT_F1));
        tr_matrix(F, A.in[I_W_FF2] + (size_t)l * DFF * DM, DFF, DM, nullptr, (bf16*)(wl + WT_F2));
    }
    {
        const int gw = blockIdx.x * NWAVES + F.wave, NGW = F.G * NWAVES;
        float* ss = (float*)(F.ctl + CW_SS);
        for (int m = gw; m < M; m += NGW) {
            const GAS f32x4* xr = (const GAS f32x4*)(A.in[I_X] + (size_t)m * DM) + F.lane; GAS v2u* o = (GAS v2u*)((bf16*)(ws + WS_XB) + (size_t)m * DM) + F.lane; float s = 0.f;
#pragma unroll 4
            for (int j = 0; j < 16; ++j) { const f32x4 v = xr[64 * j]; s += (v.x * v.x + v.y * v.y) + (v.z * v.z + v.w * v.w); v2u w; w.x = cvtpk(v.x, v.y); w.y = cvtpk(v.z, v.w); o[64 * j] = w; }
            s = wave_sum(s); if (F.lane == 0) ss[m] = s;
        }
    }
    {
        float* tab = (float*)(ws + WS_TAB);
        const int gt = blockIdx.x * (NWAVES * 64) + F.tid;
        if (gt < NL * NGRP * NST) {
            const int l = gt / (NGRP * NST), g = (gt / NST) % NGRP, p = gt % NST;
            const double lr = (double)fminf(A.in[I_A_RE][gt], -1e-4f), li = (double)A.in[I_A_IM][gt];
            const double dt = d_exp((double)A.in[I_LOG_DT][l * NGRP + g]);
            double e = d_exp(lr * dt), sn, cs; d_sincos(li * dt, sn, cs);
            const double ar = e * cs, ai = e * sn;
            tab[TAB_A + 2 * gt] = (float)ar; tab[TAB_A + 2 * gt + 1] = (float)ai;
            e = d_exp(lr * dt * 64.0); d_sincos(li * dt * 64.0, sn, cs);
            tab[TAB_AL + 2 * gt] = (float)(e * cs); tab[TAB_AL + 2 * gt + 1] = (float)(e * sn);
            const double nr = ar - 1.0, ni = ai, den = lr * lr + li * li, fr = (nr * lr + ni * li) / den, fi = (ni * lr - nr * li) / den;
#pragma unroll 4
            for (int h = 0; h < 16; ++h) { const double br = (double)A.in[I_B_RE][(size_t)gt * 16 + h], bi = (double)A.in[I_B_IM][(size_t)gt * 16 + h];
                tab[TAB_B + ((size_t)gt * 16 + h) * 2] = (float)(fr * br - fi * bi); tab[TAB_B + ((size_t)gt * 16 + h) * 2 + 1] = (float)(fr * bi + fi * br); }
        }
        if (gt < NL) {
            double s1 = 0.0, s2 = 0.0;
            for (int i = 0; i < HD; ++i) { s1 += (double)A.in[I_LQ1][gt * HD + i] * (double)A.in[I_LK1][gt * HD + i]; s2 += (double)A.in[I_LQ2][gt * HD + i] * (double)A.in[I_LK2][gt * HD + i]; }
            tab[TAB_LAM + gt] = (float)(d_exp(s1) - d_exp(s2) + (double)lambda_init_of(gt));
        }
    }
}

__device__ __forceinline__ void qknorm_rows(const Frame& F, const Args& A, int l) {
    int lane_ = F.lane; asm volatile("" : "+v"(lane_));
    const int gw = blockIdx.x * NWAVES + F.wave, NGW = F.G * NWAVES, sub = lane_ >> 4, l16 = lane_ & 15;
    bf16* QKV = (bf16*)(A.ws + WS_QKV);
    for (int m = gw; m < M; m += NGW) {
#pragma unroll 2
        for (int i = 0; i < 12; ++i) {
            const int seg = i * 4 + sub, which = seg / 12, s12 = seg - which * 12;
            const int col = (which == 0 ? 0 : which == 1 ? 1536 : which == 2 ? 4608 : 6144) + s12 * 128 + l16 * 8;
            const float* gp = A.in[which == 0 ? I_CA_QG : which == 1 ? I_CA_KG : which == 2 ? I_DA_QG : I_DA_KG] + l * HD + l16 * 8;
            GAS v4u* p = (GAS v4u*)(QKV + (size_t)m * QKVW + col); const v4u w = *p;
            float x[8] = {bflo(w.x), bfhi(w.x), bflo(w.y), bfhi(w.y), bflo(w.z), bfhi(w.z), bflo(w.w), bfhi(w.w)};
            float s = 0.f;
#pragma unroll
            for (int j = 0; j < 8; ++j) s += x[j] * x[j];
            s += __shfl_xor(s, 1); s += __shfl_xor(s, 2); s += __shfl_xor(s, 4); s += __shfl_xor(s, 8);
            const float r = rsqrtf(s * (1.0f / 128.0f) + EPS) * ((which & 1) ? 1.0f : QSCALE);
            const f32x4 g0 = *(const f32x4*)gp, g1 = *(const f32x4*)(gp + 4);
            v4u o; o.x = cvtpk(x[0] * r * g0[0], x[1] * r * g0[1]); o.y = cvtpk(x[2] * r * g0[2], x[3] * r * g0[3]); o.z = cvtpk(x[4] * r * g1[0], x[5] * r * g1[1]); o.w = cvtpk(x[6] * r * g1[2], x[7] * r * g1[3]);
            *p = o;
        }
    }
}

__device__ __forceinline__ float gelu_tanh(float y) { const float t = 0.7978845608028654f * (y + 0.044715f * y * y * y); const float e = __expf(2.0f * t); return 0.5f * y * (2.0f - 2.0f / (e + 1.0f)); }
__device__ __forceinline__ void naive_ssm(const Frame& F, const Args& A, int l) {
    int p_ = F.lane; asm volatile("" : "+v"(p_)); const int p = p_;
    const int gw = blockIdx.x * NWAVES + F.wave, NGW = F.G * NWAVES;
    const float* tab = (const float*)(A.ws + WS_TAB); const float* UA = (const float*)(A.ws + WS_UA); bf16* Z = (bf16*)(A.ws + WS_Z);
    LAS float* us = (LAS float*)(F.lds + RING_OFF + F.wave * 4096);
    for (int it = gw; it < NB * NGRP; it += NGW) {
        const int b = it / NGRP, g = it % NGRP, gi = (l * NGRP + g) * NST + p;
        const float ar = tab[TAB_A + 2 * gi], ai = tab[TAB_A + 2 * gi + 1];
        float Br[16], Bi[16], Cr[16], Ci[16];
#pragma unroll
        for (int h = 0; h < 16; ++h) { Br[h] = tab[TAB_B + ((size_t)gi * 16 + h) * 2]; Bi[h] = tab[TAB_B + ((size_t)gi * 16 + h) * 2 + 1];
            Cr[h] = A.in[I_C_RE][((size_t)(l * NGRP + g) * 16 + h) * NST + p]; Ci[h] = A.in[I_C_IM][((size_t)(l * NGRP + g) * 16 + h) * NST + p]; }
        const float dsk = A.in[I_SSM_D][l * SSMW + g * 16 + (p & 15)];
        float xr = 0.f, xi = 0.f;
        for (int s0 = 0; s0 < SEQ; s0 += 64) {
#pragma unroll
            for (int j = 0; j < 4; ++j) { const int idx = p + 64 * j, t = idx >> 2, q = idx & 3;
                *(LAS f32x4*)(us + t * 16 + q * 4) = *(const GAS f32x4*)(UA + (size_t)(b * SEQ + s0 + t) * SSMW + g * 16 + q * 4); }
            LDS_WAIT(); asm volatile("" ::: "memory");
            for (int t = 0; t < 64; ++t) {
                float u[16];
#pragma unroll
                for (int q = 0; q < 4; ++q) { const f32x4 uv = *(const LAS f32x4*)(us + t * 16 + q * 4); u[4 * q] = uv[0]; u[4 * q + 1] = uv[1]; u[4 * q + 2] = uv[2]; u[4 * q + 3] = uv[3]; }
                float bur = 0.f, bui = 0.f;
#pragma unroll
                for (int h = 0; h < 16; ++h) { bur += Br[h] * u[h]; bui += Bi[h] * u[h]; }
                const float nxr = ar * xr - ai * xi + bur, nxi = ar * xi + ai * xr + bui; xr = nxr; xi = nxi;
                float yy = 0.f;
#pragma unroll
                for (int h = 0; h < 16; ++h) { const float sm = wave_sum(Cr[h] * xr - Ci[h] * xi); yy = (p == h) ? sm : yy; }
                if (p < 16) { const float y = yy + dsk * us[t * 16 + p]; const float z = gelu_tanh(y);
                    Z[(size_t)(b * SEQ + s0 + t) * SSMW + g * 16 + p] = (bf16)(cvtpk(z, z) & 0xffffu); }
            }
            LDS_WAIT(); asm volatile("" ::: "memory");
        }
    }
}
__device__ __forceinline__ void naive_band(const Frame& F, const Args& A, int l) {
    int lane_ = F.lane; asm volatile("" : "+v"(lane_)); const int lane = lane_;
    const int gw = blockIdx.x * NWAVES + F.wave, NGW = F.G * NWAVES;
    const bf16* QKV = (const bf16*)(A.ws + WS_QKV); bf16* YB = (bf16*)(A.ws + WS_YB);
    LAS float* qs = (LAS float*)(F.lds + RING_OFF + F.wave * 1024);
    for (int it = gw; it < M * CA_H; it += NGW) {
        const int m = it / CA_H, h = it % CA_H, b = m / SEQ, s = m % SEQ, c = s >> 6;
        { const unsigned w = *(const GAS unsigned*)(QKV + (size_t)m * QKVW + h * HD + 2 * lane); qs[2 * lane] = bflo(w); qs[2 * lane + 1] = bfhi(w); }
        LDS_WAIT(); asm volatile("" ::: "memory");
        const float* rb = A.in[I_CA_BIAS] + (size_t)(l * CA_H + h) * 257;
        float a0 = 0.f, a1 = 0.f, mr = -1e30f, ls = 0.f;
        for (int t = (c > 8 ? c - 8 : 0); t <= c; ++t) {
            const int kpos = 64 * t + lane; const bf16* kp = QKV + (size_t)(b * SEQ + kpos) * QKVW + 1536 + h * HD;
            float sd = 0.f;
#pragma unroll 4
            for (int i = 0; i < 16; ++i) { const v4u kw = *(const GAS v4u*)(kp + 8 * i); const f32x4 q0 = *(const LAS f32x4*)(qs + 8 * i), q1 = *(const LAS f32x4*)(qs + 8 * i + 4);
                sd += bflo(kw.x) * q0[0] + bfhi(kw.x) * q0[1] + bflo(kw.y) * q0[2] + bfhi(kw.y) * q0[3] + bflo(kw.z) * q1[0] + bfhi(kw.z) * q1[1] + bflo(kw.w) * q1[2] + bfhi(kw.w) * q1[3]; }
            int rel = s - kpos; rel = rel < -128 ? -128 : (rel > 128 ? 128 : rel);
            sd += rb[rel + 128] * LOG2E;
            const float mn = fmaxf(mr, wave_max(sd)), alpha = exp2f(mr - mn), pe = exp2f(sd - mn);
            ls = ls * alpha + wave_sum(pe); a0 *= alpha; a1 *= alpha; mr = mn;
            const bf16* vp = QKV + (size_t)(b * SEQ + 64 * t) * QKVW + 3072 + h * HD + 2 * lane;
#pragma unroll 8
            for (int kk = 0; kk < 64; ++kk) { const float pk = __uint_as_float(__builtin_amdgcn_readlane(__float_as_uint(pe), kk)); const unsigned vw = *(const GAS unsigned*)(vp + (size_t)kk * QKVW);
                a0 += pk * bflo(vw); a1 += pk * bfhi(vw); }
        }
        const float inv = 1.0f / ls;
        *(GAS unsigned*)(YB + (size_t)m * CAW + h * HD + 2 * lane) = cvtpk(a0 * inv, a1 * inv);
        LDS_WAIT(); asm volatile("" ::: "memory");
    }
}
__device__ __forceinline__ void naive_diff(const Frame& F, const Args& A, int l) {
    int lane_ = F.lane; asm volatile("" : "+v"(lane_)); const int lane = lane_;
    const int gw = blockIdx.x * NWAVES + F.wave, NGW = F.G * NWAVES;
    const bf16* QKV = (const bf16*)(A.ws + WS_QKV); bf16* YC = (bf16*)(A.ws + WS_YC);
    LAS float* qs = (LAS float*)(F.lds + RING_OFF + F.wave * 1024);
    const float lam = ((const float*)(A.ws + WS_TAB))[TAB_LAM + l], li1 = 1.0f - lambda_init_of(l);
    for (int it = gw; it < M * DA_H; it += NGW) {
        const int m = it / DA_H, h = it % DA_H, b = m / SEQ, s = m % SEQ, c = s >> 6;
        { const v2u w = *(const GAS v2u*)(QKV + (size_t)m * QKVW + 4608 + h * 256 + 4 * lane); qs[4 * lane] = bflo(w.x); qs[4 * lane + 1] = bfhi(w.x); qs[4 * lane + 2] = bflo(w.y); qs[4 * lane + 3] = bfhi(w.y); }
        LDS_WAIT(); asm volatile("" ::: "memory");
        const float slope2 = exp2f(-8.0f * (float)(h + 1) / (float)DA_H) * LOG2E;
        float acc[2][4] = {{0.f, 0.f, 0.f, 0.f}, {0.f, 0.f, 0.f, 0.f}}, mr[2] = {-1e30f, -1e30f}, ls[2] = {0.f, 0.f};
        for (int t = 0; t <= c; ++t) {
            const int kpos = 64 * t + lane; const int dist = s > kpos ? s - kpos : kpos - s; const float bias = -slope2 * (float)dist;
            float pe[2];
#pragma unroll
            for (int mp = 0; mp < 2; ++mp) {
                const bf16* kp = QKV + (size_t)(b * SEQ + kpos) * QKVW + 6144 + h * 256 + mp * HD; float sd = 0.f;
#pragma unroll 4
                for (int i = 0; i < 16; ++i) { const v4u kw = *(const GAS v4u*)(kp + 8 * i); const f32x4 q0 = *(const LAS f32x4*)(qs + mp * HD + 8 * i), q1 = *(const LAS f32x4*)(qs + mp * HD + 8 * i + 4);
                    sd += bflo(kw.x) * q0[0] + bfhi(kw.x) * q0[1] + bflo(kw.y) * q0[2] + bfhi(kw.y) * q0[3] + bflo(kw.z) * q1[0] + bfhi(kw.z) * q1[1] + bflo(kw.w) * q1[2] + bfhi(kw.w) * q1[3]; }
                sd += bias;
                const float mn = fmaxf(mr[mp], wave_max(sd)), alpha = exp2f(mr[mp] - mn); pe[mp] = exp2f(sd - mn);
                ls[mp] = ls[mp] * alpha + wave_sum(pe[mp]); mr[mp] = mn;
#pragma unroll
                for (int j = 0; j < 4; ++j) acc[mp][j] *= alpha;
            }
            const bf16* vp = QKV + (size_t)(b * SEQ + 64 * t) * QKVW + 7680 + h * 256 + 4 * lane;
#pragma unroll 8
            for (int kk = 0; kk < 64; ++kk) { const float p0 = __uint_as_float(__builtin_amdgcn_readlane(__float_as_uint(pe[0]), kk)), p1 = __uint_as_float(__builtin_amdgcn_readlane(__float_as_uint(pe[1]), kk));
                const v2u vw = *(const GAS v2u*)(vp + (size_t)kk * QKVW); const float v0 = bflo(vw.x), v1 = bfhi(vw.x), v2 = bflo(vw.y), v3 = bfhi(vw.y);
                acc[0][0] += p0 * v0; acc[0][1] += p0 * v1; acc[0][2] += p0 * v2; acc[0][3] += p0 * v3; acc[1][0] += p1 * v0; acc[1][1] += p1 * v1; acc[1][2] += p1 * v2; acc[1][3] += p1 * v3; }
        }
        const float i0 = 1.0f / ls[0], i1 = lam / ls[1]; float o[4], sq = 0.f;
#pragma unroll
        for (int j = 0; j < 4; ++j) { o[j] = acc[0][j] * i0 - acc[1][j] * i1; sq += o[j] * o[j]; }
        sq = wave_sum(sq); const float r = rsqrtf(sq * (1.0f / 256.0f) + EPS) * li1;
        const f32x4 gn = *(const f32x4*)(A.in[I_SUBLN] + l * 256 + 4 * lane);
        v2u w; w.x = cvtpk(o[0] * r * gn[0], o[1] * r * gn[1]); w.y = cvtpk(o[2] * r * gn[2], o[3] * r * gn[3]);
        *(GAS v2u*)(YC + (size_t)m * DAW + h * 256 + 4 * lane) = w;
        LDS_WAIT(); asm volatile("" ::: "memory");
    }
}

#ifndef PHM
#define PHM 0x1ff
#endif
__global__ void __launch_bounds__(NWAVES * 64, 2) mk_fwd(Args args) {
    extern __shared__ __attribute__((aligned(16))) unsigned char lds[];
    Frame F;
    F.lds = (LAS unsigned char*)lds;
    F.MISC = (volatile LAS unsigned*)(F.lds + MISC_OFF);
    F.tid = threadIdx.x; F.lane = F.tid & 63; F.wave = __builtin_amdgcn_readfirstlane(F.tid >> 6);
    F.G = gridDim.x; F.in = nullptr; F.ws = args.ws;
    unsigned char* ws = args.ws;
    F.ctl = (gu32*)(ws + WS_CTL);
    for (int u = F.tid; u < (LDS_BYTES - LDSCTL_OFF) / 4; u += NWAVES * 64) ((LAS unsigned*)(F.lds + LDSCTL_OFF))[u] = 0u;
    __syncthreads();
    XcdBarrier bar; bar.bar = (unsigned*)(F.ctl + CW_BAR); bar.x = 0; bar.st = nullptr;
    if (N_LAUNCHES == 1) bar = xcd_barrier_post((unsigned*)(F.ctl + CW_BAR), F.MISC + 8);
#define GRID_BAR() do { if (N_LAUNCHES != 1) { if (F.tid == 0) __hip_atomic_store(F.ctl + CW_TMO, 0xBADBA0u, RLX_AGENT); } else { xcd_barrier(bar); } } while (0)
    const int lo = args.ph_lo, hi = args.ph_hi;
#define IN(k) (lo <= (k) && (k) < hi)
#define BOTH(k) (IN(k) && IN((k) + 1))

    if (((PHM >> 8) & 1) && IN(0)) { p0_prologue(F, args); if (BOTH(0)) GRID_BAR(); }

    for (int l = 0; l < NL; ++l) {
        const int pb = 1 + 8 * l;
        unsigned char* wl = ws + WS_WT + (size_t)l * WT_LAYER;
        float* ss_in = (float*)(F.ctl + CW_SS) + (size_t)l * M;
        float* ss_mid = (float*)(F.ctl + CW_SS) + (size_t)(NL + l) * M;
        float* ss_next = (l + 1 < NL) ? (float*)(F.ctl + CW_SS) + (size_t)(l + 1) * M : nullptr;
        pg8::bf16_t* XB = (pg8::bf16_t*)(ws + WS_XB);
        float* X1 = (float*)(ws + WS_X1);
        const float* xin = (l == 0) ? args.in[I_X] : (const float*)args.out;

        if (((PHM >> 0) & 1) && IN(pb + 0)) {
            pg8::Gemm g{XB, (const pg8::bf16_t*)(wl + WT_IN), M, INW, DM}; pg8::StaticOrder S; S.init(M, INW, F.G, (int)blockIdx.x);
            pg8::EpiIn E{ss_in, (float*)(ws + WS_UA), (pg8::bf16_t*)(ws + WS_QKV), (pg8::bf16_t*)(ws + WS_GT)};
            pg8::gemm_phase<pg8::EpiIn, pg8::StaticOrder, true, true>(F.lds + RING_OFF, g, S, E);
            if (BOTH(pb + 0)) GRID_BAR();
        }
        if (((PHM >> 1) & 1) && IN(pb + 1)) {
            qknorm_rows(F, args, l);
            if (BOTH(pb + 1)) GRID_BAR();
        }
        if (((PHM >> 2) & 1) && IN(pb + 2)) {
            naive_ssm(F, args, l);
            naive_band(F, args, l);
            naive_diff(F, args, l);
            if (BOTH(pb + 2)) GRID_BAR();
        }
        if (((PHM >> 3) & 1) && IN(pb + 3)) {
            pg8::Gemm g{(const pg8::bf16_t*)(ws + WS_Z), (const pg8::bf16_t*)(wl + WT_GLU), M, SSMW, SSMW}; pg8::StaticOrder S; S.init(M, SSMW, F.G, (int)blockIdx.x);
            pg8::EpiGlu E{(const pg8::bf16_t*)(ws + WS_Z), args.in[I_B_GLU] + l * SSMW, (pg8::bf16_t*)(ws + WS_YA)};
            pg8::gemm_phase<pg8::EpiGlu, pg8::StaticOrder, true, true>(F.lds + RING_OFF, g, S, E);
            if (BOTH(pb + 3)) GRID_BAR();
        }
        if (((PHM >> 4) & 1) && IN(pb + 4)) {
            const pg8::bf16_t* GT = (const pg8::bf16_t*)(ws + WS_GT); float* MF = (float*)(ws + WS_MF); pg8::bf16_t* MB = (pg8::bf16_t*)(ws + WS_MB);
            pg8::StaticOrder S; S.init(M, DM, F.G, (int)blockIdx.x);
            { pg8::Gemm g{(const pg8::bf16_t*)(ws + WS_YA), (const pg8::bf16_t*)(wl + WT_OA), M, DM, SSMW}; pg8::EpiMerge<0> E{GT, 0, MF, MB};
              pg8::gemm_phase<pg8::EpiMerge<0>, pg8::StaticOrder, true, true>(F.lds + RING_OFF, g, S, E); }
            { pg8::Gemm g{(const pg8::bf16_t*)(ws + WS_YB), (const pg8::bf16_t*)(wl + WT_OB), M, DM, CAW}; pg8::EpiMerge<1> E{GT, DM, MF, MB};
              pg8::gemm_phase<pg8::EpiMerge<1>, pg8::StaticOrder, true, true>(F.lds + RING_OFF, g, S, E); }
            { pg8::Gemm g{(const pg8::bf16_t*)(ws + WS_YC), (const pg8::bf16_t*)(wl + WT_OC), M, DM, DAW}; pg8::EpiMerge<2> E{GT, 2 * DM, MF, MB};
              pg8::gemm_phase<pg8::EpiMerge<2>, pg8::StaticOrder, true, true>(F.lds + RING_OFF, g, S, E); }
            if (BOTH(pb + 4)) GRID_BAR();
        }
        if (((PHM >> 5) & 1) && IN(pb + 5)) {
            pg8::Gemm g{(const pg8::bf16_t*)(ws + WS_MB), (const pg8::bf16_t*)(wl + WT_O), M, DM, DM}; pg8::StaticOrder S; S.init(M, DM, F.G, (int)blockIdx.x);
            pg8::EpiRes E{xin, X1, XB, ss_mid};
            pg8::gemm_phase<pg8::EpiRes, pg8::StaticOrder, true, true>(F.lds + RING_OFF, g, S, E);
            if (BOTH(pb + 5)) GRID_BAR();
        }
        if (((PHM >> 6) & 1) && IN(pb + 6)) {
            pg8::Gemm g{XB, (const pg8::bf16_t*)(wl + WT_F1), M, DFF, DM}; pg8::StaticOrder S; S.init(M, DFF, F.G, (int)blockIdx.x);
            pg8::EpiFf1 E{ss_mid, (pg8::bf16_t*)(ws + WS_H)};
            pg8::gemm_phase<pg8::EpiFf1, pg8::StaticOrder, true, true>(F.lds + RING_OFF, g, S, E);
            if (BOTH(pb + 6)) GRID_BAR();
        }
        if (((PHM >> 7) & 1) && IN(pb + 7)) {
            pg8::Gemm g{(const pg8::bf16_t*)(ws + WS_H), (const pg8::bf16_t*)(wl + WT_F2), M, DM, DFF}; pg8::StaticOrder S; S.init(M, DM, F.G, (int)blockIdx.x);
            pg8::EpiRes E{X1, args.out, (l + 1 < NL) ? XB : nullptr, ss_next};
            pg8::gemm_phase<pg8::EpiRes, pg8::StaticOrder, true, true>(F.lds + RING_OFF, g, S, E);
            if (BOTH(pb + 7)) GRID_BAR();
        }
    }
#undef IN
#undef BOTH
}

extern "C" void kernel_launch(void* const* d_in, const int* in_sizes, int n_in, void* d_out, int out_size, void* d_ws, size_t ws_size, hipStream_t stream) {
    static int grid = 0;
    if (grid == 0) {
        if (n_in != 30 || in_sizes[0] != M * DM || out_size != M * DM || ws_size < WS_END) {
            fprintf(stderr, "kernel_launch: built for 30 inputs, x/out of %d floats, >= %zu bytes of workspace; got n_in %d, in0 %d, out %d, ws %zu; nothing launched\n", M * DM, (size_t)WS_END, n_in, n_in > 0 ? in_sizes[0] : -1, out_size, ws_size);
            grid = -1; return; }
        int dev = 0, cus = 0, per_cu = 0;
        if (hipGetDevice(&dev) != hipSuccess || hipDeviceGetAttribute(&cus, hipDeviceAttributeMultiprocessorCount, dev) != hipSuccess) { fprintf(stderr, "kernel_launch: device query failed\n"); grid = -1; return; }
        if (hipFuncSetAttribute((const void*)mk_fwd, hipFuncAttributeMaxDynamicSharedMemorySize, LDS_BYTES) != hipSuccess) { fprintf(stderr, "kernel_launch: hipFuncSetAttribute failed\n"); grid = -1; return; }
        if (hipOccupancyMaxActiveBlocksPerMultiprocessor(&per_cu, (const void*)mk_fwd, NWAVES * 64, LDS_BYTES) != hipSuccess || per_cu < 1)
            fprintf(stderr, "kernel_launch: note: occupancy query reports %d workgroups per CU\n", per_cu);
        (void)hipGetLastError();
        grid = cus;
    }
    if (grid < 0) return;
    if (hipMemsetAsync((char*)d_ws + WS_CTL, 0, CTL_ZERO_BYTES, stream) != hipSuccess) { fprintf(stderr, "kernel_launch: memset failed\n"); return; }
    Args a{};
    for (int i = 0; i < 30; ++i) a.in[i] = (const float*)d_in[i];
    a.out = (float*)d_out; a.ws = (unsigned char*)d_ws;
    for (int li = 0; li < N_LAUNCHES; ++li) {
        a.ph_lo = (N_LAUNCHES == 1) ? 0 : li; a.ph_hi = (N_LAUNCHES == 1) ? N_PHASES : li + 1; a.li = li; a.pad = 0;
        hipLaunchKernelGGL(mk_fwd, dim3(grid), dim3(NWAVES * 64), LDS_BYTES, stream, a);
        const hipError_t le = hipPeekAtLastError();
        if (le != hipSuccess) { fprintf(stderr, "kernel_launch: launch %d failed: %s\n", li, hipGetErrorName(le)); break; }
    }
}
```

```cpp
#include <hip/hip_runtime.h>
#include <cstdio>
#include <cstdint>
#define EPI_O_UA   ((size_t)1076 << 20)
#define EPI_O_QKV  ((size_t)1108 << 20)
#define EPI_O_GT   ((size_t)1252 << 20)
#define EPI_O_GTAB (((size_t)1 << 20) + 33024 * 4)
namespace pg8 {
#define PG8_LAS __attribute__((address_space(3)))
typedef unsigned short bf16_t;
typedef short bf16x8 __attribute__((ext_vector_type(8)));
typedef float f32x4 __attribute__((ext_vector_type(4)));
typedef unsigned u32x4 __attribute__((ext_vector_type(4)));
constexpr int BM = 256, BK = 64, HALF = 128, HTB = HALF * BK * 2  , STAGE_BYTES = 8 * HTB, NXCD = 8, WGM = 8;

__host__ __device__ __forceinline__ int lds_byte(int r, int c) { const int st = (r >> 4) * 2 + (c >> 5), rr = r & 15, cc = c & 31, ob = rr * 64 + cc * 2; return st * 1024 + (ob ^ (((ob >> 9) & 1) << 5)); }
__host__ __device__ __forceinline__ void stage_rc(int b, int& R, int& C) { const int st = b / 1024, sb = b % 1024, swz = sb ^ (((sb >> 9) & 1) << 5); R = (st >> 1) * 16 + swz / 64; C = (st & 1) * 32 + (swz % 64) / 2; }
__host__ __device__ __forceinline__ int perm32(int rho) { const int n = rho >> 4, i = rho & 15; return 8 * (i >> 2) + 4 * n + (i & 3); }

struct Unit { int pm, pn; };
struct Gemm { const bf16_t* A; const bf16_t* Bt; int M, N, K; };

struct StaticOrder {
    int nM, nN, nwg, G, c;
    __host__ __device__ void init(int M, int N, int G_, int c_) { nM = M / BM; nN = N / BM; nwg = nM * nN; G = G_; c = c_; }
    __host__ __device__ bool next(int i, Unit& u) const {
        const long L = (long)i * G + c; if (L >= nwg) return false;
        int wgid = (int)L; { const int q = nwg / NXCD, r = nwg % NXCD, xcd = wgid % NXCD, off = wgid / NXCD; wgid = (xcd < r ? xcd * (q + 1) : r * (q + 1) + (xcd - r) * q) + off; }
        const int nig = WGM * nN, gid = wgid / nig, fm = gid * WGM, gsz = (nM - fm) < WGM ? (nM - fm) : WGM;
        u.pm = fm + ((wgid % nig) % gsz); u.pn = (wgid % nig) / gsz; return true;
    }
    __device__ __forceinline__ void a_ready(const Unit&) const {}
    __device__ __forceinline__ void done(const Unit&) const {}
};

struct InterleavedOrder : StaticOrder {
    __host__ __device__ bool next(int i, Unit& u) const { if (!StaticOrder::next(i, u)) return false; const int half = nN >> 1; u.pn = (u.pn % half) * 2 + u.pn / half; return true; }
};
typedef float f32x2_cv __attribute__((ext_vector_type(2))); typedef __bf16 bf16x2_cv __attribute__((ext_vector_type(2)));
__device__ __forceinline__ unsigned cvt_pk_bf16(float lo, float hi) { const f32x2_cv v = {lo, hi}; const bf16x2_cv b = __builtin_convertvector(v, bf16x2_cv); return __builtin_bit_cast(unsigned, b); }
typedef float f32x2 __attribute__((ext_vector_type(2)));
__device__ __forceinline__ u32x4 pack8(f32x4 v0, f32x4 v1) { u32x4 w; w.x = cvt_pk_bf16(v0[0], v0[1]); w.y = cvt_pk_bf16(v0[2], v0[3]); w.z = cvt_pk_bf16(v1[0], v1[1]); w.w = cvt_pk_bf16(v1[2], v1[3]); return w; }
__device__ __forceinline__ void unpack8(u32x4 w, f32x4& v0, f32x4& v1) {
    v0[0] = __uint_as_float(w.x << 16); v0[1] = __uint_as_float(w.x & 0xffff0000u); v0[2] = __uint_as_float(w.y << 16); v0[3] = __uint_as_float(w.y & 0xffff0000u);
    v1[0] = __uint_as_float(w.z << 16); v1[1] = __uint_as_float(w.z & 0xffff0000u); v1[2] = __uint_as_float(w.w << 16); v1[3] = __uint_as_float(w.w & 0xffff0000u); }
__device__ __forceinline__ float sigm(float x) { return __builtin_amdgcn_rcpf(1.0f + __builtin_amdgcn_exp2f(-1.4426950408889634f * x)); }
__device__ __forceinline__ f32x4 sigm4(f32x4 v) { f32x4 o; o[0] = sigm(v[0]); o[1] = sigm(v[1]); o[2] = sigm(v[2]); o[3] = sigm(v[3]); return o; }

__device__ __forceinline__ float rms_from_slots(const float* ssp, int row) {
    const f32x4* p = (const f32x4*)(ssp + (size_t)row * 64); float s = 0.f;
#pragma unroll
    for (int i = 0; i < 16; ++i) { const f32x4 v = p[i]; s += (v[0] + v[1]) + (v[2] + v[3]); }
    return rsqrtf(s * (1.0f / 4096.0f) + 1e-6f);
}
struct RowScale { const float* ssp; PG8_LAS const float* rtab; int pm0;
    __device__ __forceinline__ float get(int pm, int rloc) const { (void)pm; return rtab[rloc]; } };
struct EpiIn {
    static constexpr bool PERM = true, AFTER_DRAIN = false;
    unsigned char* ws; PG8_LAS unsigned char* ldsb; int layer;
    static constexpr size_t O_UA = EPI_O_UA, O_QKV = EPI_O_QKV, O_GT = EPI_O_GT, O_GTAB = EPI_O_GTAB;
    __device__ __forceinline__ void operator()(const f32x4 (&acc)[2][2][4][2], const Unit& u, int wr, int wc, int fr, int fq) const {
        float* UA = (float*)(ws + O_UA); bf16_t* QKV = (bf16_t*)(ws + O_QKV); bf16_t* GT = (bf16_t*)(ws + O_GT);
        const RowScale rs{nullptr, (PG8_LAS const float*)ldsb, 0}; PG8_LAS float* ptab = (PG8_LAS float*)(ldsb + 1024);
        const int row0 = u.pm * BM + wr * 64 + fr, colt = u.pn * BM, cin = wc * 32 + 8 * fq;
        const int sec = (colt - 1024) / 1536;
        const bool qk = colt >= 1024 && colt < 10240 && sec != 2 && sec != 5;
        if (qk) {
#pragma unroll
            for (int ai = 0; ai < 2; ++ai)
#pragma unroll
                for (int m = 0; m < 4; ++m) { const int rloc = ai * HALF + wr * 64 + m * 16 + fr; const float r = rs.get(u.pm, rloc);
#pragma unroll
                    for (int bj = 0; bj < 2; ++bj) { const f32x4 v0 = acc[ai][bj][m][0] * r, v1 = acc[ai][bj][m][1] * r;
                        float q = (v0[0] * v0[0] + v0[1] * v0[1]) + (v0[2] * v0[2] + v0[3] * v0[3]) + (v1[0] * v1[0] + v1[1] * v1[1]) + (v1[2] * v1[2] + v1[3] * v1[3]);
                        q += __shfl_xor(q, 16); q += __shfl_xor(q, 32);
                        if (fq == 0) ptab[(rloc * 2 + bj) * 4 + wc] = q; } }
            asm volatile("s_waitcnt lgkmcnt(0)" ::: "memory"); __builtin_amdgcn_s_barrier(); asm volatile("" ::: "memory");
            int cin2 = cin; asm volatile("" : "+v"(cin2));
            PG8_LAS const float* gp = (PG8_LAS const float*)(ldsb + 9216) + (sec - (sec >= 3 ? 1 : 0)) * 128 + cin2;
            const f32x4 g0 = *(PG8_LAS const f32x4*)gp, g1 = *(PG8_LAS const f32x4*)(gp + 4);
#pragma unroll
            for (int ai = 0; ai < 2; ++ai)
#pragma unroll
                for (int m = 0; m < 4; ++m) { const int rloc = ai * HALF + wr * 64 + m * 16 + fr; const int row = u.pm * BM + rloc; const float r = rs.get(u.pm, rloc);
#pragma unroll
                    for (int bj = 0; bj < 2; ++bj) { const f32x4 pq = *(const PG8_LAS f32x4*)(ptab + (rloc * 2 + bj) * 4);
                        const float rr = r * rsqrtf(((pq[0] + pq[1]) + (pq[2] + pq[3])) * (1.0f / 128.0f) + 1e-6f);
                        *(u32x4*)(QKV + (size_t)row * 9216 + (colt - 1024) + cin + bj * HALF) = pack8(acc[ai][bj][m][0] * rr * g0, acc[ai][bj][m][1] * rr * g1); }
                    asm volatile("" ::: "memory"); }
            return;
        }
#pragma unroll
        for (int ai = 0; ai < 2; ++ai)
#pragma unroll
            for (int m = 0; m < 4; ++m) { const int row = row0 + ai * HALF + m * 16; const float r = rs.get(u.pm, ai * HALF + wr * 64 + m * 16 + fr);
#pragma unroll
                for (int bj = 0; bj < 2; ++bj) { f32x4 v0 = acc[ai][bj][m][0] * r, v1 = acc[ai][bj][m][1] * r; const int c = cin + bj * HALF;
                    if (colt < 1024) { float* p = UA + (size_t)row * 1024 + colt + c; *(f32x4*)p = v0; *(f32x4*)(p + 4) = v1; }
                    else if (colt < 10240) { *(u32x4*)(QKV + (size_t)row * 9216 + (colt - 1024) + c) = pack8(v0, v1); }
                    else { *(u32x4*)(GT + (size_t)row * 12288 + (colt - 10240) + c) = pack8(sigm4(v0), sigm4(v1)); } }
                asm volatile("" ::: "memory"); }
    }
};
__device__ __forceinline__ unsigned q8x4(f32x4 g) { const unsigned a = (unsigned)(g[0] * 255.0f + 0.5f), b = (unsigned)(g[1] * 255.0f + 0.5f), c = (unsigned)(g[2] * 255.0f + 0.5f), d = (unsigned)(g[3] * 255.0f + 0.5f);
    return a | (b << 8) | (c << 16) | (d << 24); }
__device__ __forceinline__ f32x4 dq8x4(unsigned w) { f32x4 o; o[0] = (float)(w & 0xffu); o[1] = (float)((w >> 8) & 0xffu); o[2] = (float)((w >> 16) & 0xffu); o[3] = (float)(w >> 24); return o * (1.0f / 255.0f); }
struct EpiGate {
    static constexpr bool PERM = true, AFTER_DRAIN = false;
    PG8_LAS const float* rtab; unsigned char* GT; float inv_wscale;
    __device__ __forceinline__ void operator()(const f32x4 (&acc)[2][2][4][2], const Unit& u, int wr, int wc, int fr, int fq) const {
        const int row0 = u.pm * BM + wr * 64 + fr, cb = u.pn * BM + wc * 64 + fq * 16;
#pragma unroll
        for (int ai = 0; ai < 2; ++ai)
#pragma unroll
            for (int m = 0; m < 4; ++m) { const int row = row0 + ai * HALF + m * 16; const float r = rtab[ai * HALF + wr * 64 + m * 16 + fr] * inv_wscale;
                u32x4 w; w.x = q8x4(sigm4(acc[ai][0][m][0] * r)); w.y = q8x4(sigm4(acc[ai][0][m][1] * r)); w.z = q8x4(sigm4(acc[ai][1][m][0] * r)); w.w = q8x4(sigm4(acc[ai][1][m][1] * r));
                *(u32x4*)(GT + (size_t)row * 12288 + cb) = w;
                asm volatile("" ::: "memory"); }
    }
};
struct EpiGlu {
    static constexpr bool PERM = true, AFTER_DRAIN = false;
    const bf16_t* Z; const float* bias; bf16_t* YA;
    __device__ __forceinline__ void operator()(const f32x4 (&acc)[2][2][4][2], const Unit& u, int wr, int wc, int fr, int fq) const {
        const int row0 = u.pm * BM + wr * 64 + fr, col0 = u.pn * BM + wc * 32 + 8 * fq;
        f32x4 bv[2][2];
#pragma unroll
        for (int bj = 0; bj < 2; ++bj)
#pragma unroll
            for (int n = 0; n < 2; ++n) bv[bj][n] = *(const f32x4*)(bias + col0 + bj * HALF + 4 * n);
        u32x4 zr[4][2];
#define EG_LOAD(g_) do { const size_t o_ = (size_t)(row0 + ((g_) >> 2) * HALF + ((g_) & 3) * 16) * 1024 + col0; zr[(g_) & 3][0] = *(const u32x4*)(Z + o_); zr[(g_) & 3][1] = *(const u32x4*)(Z + o_ + HALF); } while (0)
        EG_LOAD(0); EG_LOAD(1); EG_LOAD(2);
#pragma unroll
        for (int g = 0; g < 8; ++g) { const int ai = g >> 2, m = g & 3; const size_t off = (size_t)(row0 + ai * HALF + m * 16) * 1024 + col0;
            const u32x4 zw0 = zr[g & 3][0], zw1 = zr[g & 3][1];
            if (g + 3 < 8) EG_LOAD(g + 3);
#pragma unroll
            for (int bj = 0; bj < 2; ++bj) { f32x4 z0, z1; unpack8(bj ? zw1 : zw0, z0, z1);
                const f32x4 v0 = z0 * sigm4(acc[ai][bj][m][0] + bv[bj][0]), v1 = z1 * sigm4(acc[ai][bj][m][1] + bv[bj][1]);
                *(u32x4*)(YA + off + bj * HALF) = pack8(v0, v1); }
            asm volatile("" ::: "memory"); }
#undef EG_LOAD
    }
};
template <int MODE> struct EpiMerge {
    static constexpr bool PERM = true, AFTER_DRAIN = false;
    const unsigned char* GT; int goff; bf16_t* MS; bf16_t* MB;
    __device__ __forceinline__ void operator()(const f32x4 (&acc)[2][2][4][2], const Unit& u, int wr, int wc, int fr, int fq) const {
        const int row0 = u.pm * BM + wr * 64 + fr, col0 = u.pn * BM + wc * 32 + 8 * fq, cb = goff + u.pn * BM + wc * 64 + fq * 16;
        u32x4 gwr[4], msr[4][2];
#define EM_LOAD(g_) do { const int row_ = row0 + ((g_) >> 2) * HALF + ((g_) & 3) * 16; gwr[(g_) & 3] = *(const u32x4*)(GT + (size_t)row_ * 12288 + cb); \
            if (MODE >= 1) { msr[(g_) & 3][0] = *(const u32x4*)(MS + (size_t)row_ * 4096 + col0); msr[(g_) & 3][1] = *(const u32x4*)(MS + (size_t)row_ * 4096 + col0 + HALF); } } while (0)
        EM_LOAD(0); EM_LOAD(1); EM_LOAD(2);
#pragma unroll
        for (int g = 0; g < 8; ++g) { const int ai = g >> 2, m = g & 3, row = row0 + ai * HALF + m * 16; const size_t off = (size_t)row * 4096 + col0;
            const u32x4 gw = gwr[g & 3]; const u32x4 m0 = msr[g & 3][0], m1 = msr[g & 3][1];
            if (g + 3 < 8) EM_LOAD(g + 3);
#pragma unroll
            for (int bj = 0; bj < 2; ++bj) { const f32x4 g0 = dq8x4(bj ? gw.z : gw.x), g1 = dq8x4(bj ? gw.w : gw.y);
                f32x4 v0 = g0 * acc[ai][bj][m][0], v1 = g1 * acc[ai][bj][m][1];
                if (MODE >= 1) { f32x4 s0, s1; unpack8(bj ? m1 : m0, s0, s1); v0 += s0; v1 += s1; }
                *(u32x4*)((MODE <= 1 ? MS : MB) + off + bj * HALF) = pack8(v0, v1); }
            asm volatile("" ::: "memory"); }
#undef EM_LOAD
    }
};
struct EpiRes {
    static constexpr bool PERM = true, AFTER_DRAIN = false;
    const float* base; float* outf; bf16_t* XB; float* ssp; unsigned char* XB8;
    __device__ __forceinline__ void operator()(const f32x4 (&acc)[2][2][4][2], const Unit& u, int wr, int wc, int fr, int fq) const {
        const int row0 = u.pm * BM + wr * 64 + fr, col0 = u.pn * BM + wc * 32 + 8 * fq;
        f32x4 bb[3][4];
#define ER_LOAD(g_) do { const float* bp_ = base + (size_t)(row0 + ((g_) >> 2) * HALF + ((g_) & 3) * 16) * 4096 + col0; \
            bb[(g_) % 3][0] = *(const f32x4*)bp_; bb[(g_) % 3][1] = *(const f32x4*)(bp_ + 4); bb[(g_) % 3][2] = *(const f32x4*)(bp_ + HALF); bb[(g_) % 3][3] = *(const f32x4*)(bp_ + HALF + 4); } while (0)
        ER_LOAD(0); ER_LOAD(1);
#pragma unroll
        for (int g = 0; g < 8; ++g) { const int ai = g >> 2, m = g & 3, row = row0 + ai * HALF + m * 16; const size_t off = (size_t)row * 4096 + col0; float q = 0.f;
            const f32x4 b00 = bb[g % 3][0], b01 = bb[g % 3][1], b10 = bb[g % 3][2], b11 = bb[g % 3][3];
            if (g + 2 < 8) ER_LOAD(g + 2);
#pragma unroll
            for (int bj = 0; bj < 2; ++bj) { const f32x4 v0 = acc[ai][bj][m][0] + (bj ? b10 : b00), v1 = acc[ai][bj][m][1] + (bj ? b11 : b01);
                float* op = outf + off + bj * HALF; *(f32x4*)op = v0; *(f32x4*)(op + 4) = v1;
                if (XB) *(u32x4*)(XB + off + bj * HALF) = pack8(v0, v1);
                if (XB8) { typedef unsigned u32x2_ __attribute__((ext_vector_type(2))); u32x2_ w8; { int w = 0; w = __builtin_amdgcn_cvt_pk_fp8_f32(v0[0], v0[1], w, false); w = __builtin_amdgcn_cvt_pk_fp8_f32(v0[2], v0[3], w, true); w8.x = (unsigned)w; }
                    { int w = 0; w = __builtin_amdgcn_cvt_pk_fp8_f32(v1[0], v1[1], w, false); w = __builtin_amdgcn_cvt_pk_fp8_f32(v1[2], v1[3], w, true); w8.y = (unsigned)w; } *(u32x2_*)(XB8 + off + bj * HALF) = w8; }
                q += (v0[0] * v0[0] + v0[1] * v0[1]) + (v0[2] * v0[2] + v0[3] * v0[3]) + (v1[0] * v1[0] + v1[1] * v1[1]) + (v1[2] * v1[2] + v1[3] * v1[3]); }
            if (ssp) { q += __shfl_xor(q, 16); q += __shfl_xor(q, 32); if (fq == 0) ssp[(size_t)row * 64 + u.pn * 4 + wc] = q; }
            asm volatile("" ::: "memory"); }
#undef ER_LOAD
    }
};
struct EpiFf1 {
    static constexpr bool PERM = true, AFTER_DRAIN = false;
    RowScale rs; bf16_t* H;
    __device__ __forceinline__ void operator()(const f32x4 (&acc)[2][2][4][2], const Unit& u, int wr, int wc, int fr, int fq) const {
        const int row0 = u.pm * BM + wr * 64 + fr, col0 = u.pn * BM + wc * 32 + 8 * fq;
#pragma unroll
        for (int ai = 0; ai < 2; ++ai)
#pragma unroll
            for (int m = 0; m < 4; ++m) { const int row = row0 + ai * HALF + m * 16; const float r = rs.get(u.pm, ai * HALF + wr * 64 + m * 16 + fr);
#pragma unroll
                for (int bj = 0; bj < 2; ++bj) { f32x4 v0 = acc[ai][bj][m][0] * r, v1 = acc[ai][bj][m][1] * r;
#pragma unroll
                    for (int j = 0; j < 4; ++j) { const float a = fmaxf(v0[j], 0.f), b = fmaxf(v1[j], 0.f); v0[j] = a * a; v1[j] = b * b; }
                    *(u32x4*)(H + (size_t)row * 16384 + col0 + bj * HALF) = pack8(v0, v1); }
                asm volatile("" ::: "memory"); }
    }
};
template <class Epi, class Sched, bool ALIGN_EPI = false, bool SP2 = false, bool FP8 = false>
__device__ __forceinline__ void gemm_phase(PG8_LAS unsigned char* lds, const Gemm g, const Sched& S, const Epi& E) {
    int tid_ = threadIdx.x; asm volatile("" : "+v"(tid_));
    const int tid = tid_, wid = __builtin_amdgcn_readfirstlane(tid >> 6), lane = tid & 63, wr = wid >> 2, wc = wid & 3, fr = lane & 15, fq = lane >> 4;
    const int K = g.K, nt = K / BK;
    unsigned voffA[2], voffB[2];
#pragma unroll
    for (int i = 0; i < 2; ++i) { int R, C; stage_rc(tid * 16 + i * 8192, R, C); const int Rb = Epi::PERM ? ((R & ~31) + perm32(R & 31)) : R;
        voffA[i] = (unsigned)(R * K + C) * 2u; voffB[i] = (unsigned)(Rb * K + C) * 2u; }
    const size_t kstep = (size_t)(BK * 2);
    const size_t hstep = (size_t)HALF * K * 2;
    const size_t tstep = 2 * hstep;
    const unsigned ldsw = (unsigned)wid * 1024u;
    int aoffk[2], boffk[2];
#pragma unroll
    for (int k = 0; k < 2; ++k) { const int cc = FP8 ? (fq * 16 + k * 8) : (k * 32 + fq * 8); aoffk[k] = lds_byte(wr * 64 + fr, cc); boffk[k] = lds_byte(wc * 32 + fr, cc); }
#define PG8_SA(b, h) (((b) * 2 + (h)) * HTB)
#define PG8_SB(b, h) ((4 + (b) * 2 + (h)) * HTB)
#define PG8_STAGE(bufoff, gbase, voff) do { _Pragma("unroll") for (int _i = 0; _i < 2; ++_i) \
        __builtin_amdgcn_global_load_lds((const unsigned*)((const char*)(gbase) + (voff)[_i]), (PG8_LAS unsigned*)(lds + (bufoff) + ldsw + _i * 8192), 16, 0, 0); } while (0)
#define PG8_LDA(dst, b, h) do { _Pragma("unroll") for (int m = 0; m < 4; ++m) { if constexpr (FP8) { dst##8[m].lo = *(const PG8_LAS v4i_*)(lds + PG8_SA(b, h) + aoffk[0] + m * 2048); dst##8[m].hi = *(const PG8_LAS v4i_*)(lds + PG8_SA(b, h) + aoffk[1] + m * 2048); } \
        else { _Pragma("unroll") for (int k = 0; k < 2; ++k) dst[m][k] = *(const PG8_LAS bf16x8*)(lds + PG8_SA(b, h) + aoffk[k] + m * 2048); } } } while (0)
#define PG8_LDB(dst, b, h) do { _Pragma("unroll") for (int n = 0; n < 2; ++n) { if constexpr (FP8) { dst##8[n].lo = *(const PG8_LAS v4i_*)(lds + PG8_SB(b, h) + boffk[0] + n * 2048); dst##8[n].hi = *(const PG8_LAS v4i_*)(lds + PG8_SB(b, h) + boffk[1] + n * 2048); } \
        else { _Pragma("unroll") for (int k = 0; k < 2; ++k) dst[n][k] = *(const PG8_LAS bf16x8*)(lds + PG8_SB(b, h) + boffk[k] + n * 2048); } } } while (0)
#define PG8_MMA(ai, bj, At, Bt) do { __builtin_amdgcn_s_setprio(1); _Pragma("unroll") for (int m = 0; m < 4; ++m) _Pragma("unroll") for (int n = 0; n < 2; ++n) { \
        if constexpr (FP8) asm volatile("v_mfma_scale_f32_16x16x128_f8f6f4 %0, %1, %2, %0, %3, %3 op_sel_hi:[0,0,0]" : "+v"(acc[ai][bj][m][n]) : "v"(Bt##8[n]), "v"(At##8[m]), "v"(scl8)); \
        else { _Pragma("unroll") for (int k = 0; k < 2; ++k) acc[ai][bj][m][n] = __builtin_amdgcn_mfma_f32_16x16x32_bf16(Bt[n][k], At[m][k], acc[ai][bj][m][n], 0, 0, 0); } } \
        __builtin_amdgcn_s_setprio(0); } while (0)
#define PG8_WAIT_V(n) asm volatile("s_waitcnt vmcnt(" #n ")" ::: "memory")
#define PG8_WAIT_L(n) asm volatile("s_waitcnt lgkmcnt(" #n ")" ::: "memory")
#define PG8_BAR __builtin_amdgcn_s_barrier()
#define PG8_SCHED __builtin_amdgcn_sched_barrier(0)
    Unit cur, nxt; int ui = 0;
    if (!S.next(0, cur)) return;
    f32x4 acc[2][2][4][2];
#pragma unroll
    for (int a = 0; a < 2; ++a)
#pragma unroll
        for (int b = 0; b < 2; ++b)
#pragma unroll
            for (int m = 0; m < 4; ++m)
#pragma unroll
                for (int n = 0; n < 2; ++n) acc[a][b][m][n] = (f32x4){0.f, 0.f, 0.f, 0.f};
    bf16x8 At[4][2], B0[2][2], B1[2][2];
    typedef int v8i_ __attribute__((ext_vector_type(8))); typedef int v4i_ __attribute__((ext_vector_type(4)));
    v8i_ At8[4], B08[2], B18[2]; unsigned scl8 = 0x7f7f7f7fu; asm volatile("" : "+v"(scl8));
    (void)At8; (void)B08; (void)B18; (void)scl8;
    const char* cA = (const char*)g.A + (size_t)cur.pm * tstep; const char* cB = (const char*)g.Bt + (size_t)cur.pn * tstep;
    S.a_ready(cur);
    if constexpr (SP2) {
        PG8_STAGE(PG8_SB(0, 0), cB, voffB); PG8_STAGE(PG8_SB(0, 1), cB + hstep, voffB); PG8_STAGE(PG8_SA(0, 0), cA, voffA); PG8_STAGE(PG8_SA(0, 1), cA + hstep, voffA);
        if (wr == 1) PG8_BAR;
        PG8_WAIT_V(2); PG8_BAR;
        PG8_STAGE(PG8_SB(1, 0), cB + kstep, voffB); PG8_STAGE(PG8_SA(1, 0), cA + kstep, voffA); PG8_STAGE(PG8_SB(1, 1), cB + hstep + kstep, voffB);
        PG8_WAIT_V(6); PG8_BAR;
    } else {
        PG8_STAGE(PG8_SB(0, 0), cB, voffB); PG8_STAGE(PG8_SA(0, 0), cA, voffA); PG8_STAGE(PG8_SB(0, 1), cB + hstep, voffB); PG8_STAGE(PG8_SA(0, 1), cA + hstep, voffA);
        if (wr == 1) PG8_BAR;
        PG8_WAIT_V(4); PG8_BAR;
        PG8_STAGE(PG8_SB(1, 0), cB + kstep, voffB); PG8_STAGE(PG8_SA(1, 0), cA + kstep, voffA); PG8_STAGE(PG8_SB(1, 1), cB + hstep + kstep, voffB);
        PG8_WAIT_V(6); PG8_BAR;
    }
    for (;;) {
        const bool has_next = S.next(ui + 1, nxt);
        const char* nA = has_next ? (const char*)g.A + (size_t)nxt.pm * tstep : cA; const char* nB = has_next ? (const char*)g.Bt + (size_t)nxt.pn * tstep : cB;
        for (int t = 0; t < nt; t += 2) {
            const bool last = (t == nt - 2);
            const char* a1 = cA + (size_t)(t + 1) * kstep;
            const char* a2 = last ? nA : cA + (size_t)(t + 2) * kstep; const char* b2 = last ? nB : cB + (size_t)(t + 2) * kstep;
            const char* a3 = a2 + kstep; const char* b3 = b2 + kstep;
            if (last && has_next) S.a_ready(nxt);
            if constexpr (SP2) {
            PG8_LDB(B0, 0, 0); PG8_LDB(B1, 0, 1); PG8_SCHED; PG8_LDA(At, 0, 0); PG8_STAGE(PG8_SA(1, 1), a1 + hstep, voffA);
            PG8_WAIT_V(8); PG8_WAIT_L(0); PG8_BAR; PG8_MMA(0, 0, At, B0); PG8_MMA(0, 1, At, B1); PG8_BAR; PG8_SCHED;
            PG8_LDA(At, 0, 1); PG8_STAGE(PG8_SB(0, 0), b2, voffB); PG8_STAGE(PG8_SB(0, 1), b2 + hstep, voffB); PG8_STAGE(PG8_SA(0, 0), a2, voffA);
            PG8_WAIT_V(8); PG8_WAIT_L(0); PG8_BAR; PG8_MMA(1, 0, At, B0); PG8_MMA(1, 1, At, B1); PG8_BAR; PG8_SCHED;
            PG8_LDB(B0, 1, 0); PG8_LDB(B1, 1, 1); PG8_SCHED; PG8_LDA(At, 1, 0); PG8_STAGE(PG8_SA(0, 1), a2 + hstep, voffA);
            PG8_WAIT_V(8); PG8_WAIT_L(0); PG8_BAR; PG8_MMA(0, 0, At, B0); PG8_MMA(0, 1, At, B1); PG8_BAR; PG8_SCHED;
            PG8_LDA(At, 1, 1); PG8_STAGE(PG8_SB(1, 0), b3, voffB); PG8_STAGE(PG8_SB(1, 1), b3 + hstep, voffB); PG8_STAGE(PG8_SA(1, 0), a3, voffA);
            PG8_WAIT_V(8); PG8_WAIT_L(0); PG8_BAR; PG8_MMA(1, 0, At, B0); PG8_MMA(1, 1, At, B1); PG8_BAR; PG8_SCHED;
            } else {
            PG8_LDB(B0, 0, 0); PG8_SCHED; PG8_LDA(At, 0, 0); PG8_STAGE(PG8_SA(1, 1), a1 + hstep, voffA);
            PG8_WAIT_L(8); PG8_BAR; PG8_WAIT_L(0); PG8_MMA(0, 0, At, B0); PG8_BAR; PG8_SCHED;
            PG8_LDB(B1, 0, 1); PG8_STAGE(PG8_SB(0, 0), b2, voffB);
            PG8_BAR; PG8_WAIT_L(0); PG8_MMA(0, 1, At, B1); PG8_BAR;
            PG8_LDA(At, 0, 1); PG8_STAGE(PG8_SA(0, 0), a2, voffA);
            PG8_BAR; PG8_WAIT_L(0); PG8_MMA(1, 0, At, B0); PG8_BAR; PG8_SCHED;
            PG8_STAGE(PG8_SB(0, 1), b2 + hstep, voffB);
            PG8_WAIT_V(6); PG8_BAR; PG8_MMA(1, 1, At, B1); PG8_BAR;
            PG8_LDB(B0, 1, 0); PG8_SCHED; PG8_LDA(At, 1, 0); PG8_STAGE(PG8_SA(0, 1), a2 + hstep, voffA);
            PG8_WAIT_L(8); PG8_BAR; PG8_WAIT_L(0); PG8_MMA(0, 0, At, B0); PG8_BAR; PG8_SCHED;
            PG8_LDB(B1, 1, 1); PG8_STAGE(PG8_SB(1, 0), b3, voffB);
            PG8_BAR; PG8_WAIT_L(0); PG8_MMA(0, 1, At, B1); PG8_BAR;
            PG8_LDA(At, 1, 1); PG8_STAGE(PG8_SA(1, 0), a3, voffA);
            PG8_BAR; PG8_WAIT_L(0); PG8_MMA(1, 0, At, B0); PG8_BAR; PG8_SCHED;
            PG8_STAGE(PG8_SB(1, 1), b3 + hstep, voffB);
            PG8_WAIT_V(6); PG8_BAR; PG8_MMA(1, 1, At, B1); PG8_BAR;
            }
        }
        if constexpr (ALIGN_EPI) { if (wr == 0) PG8_BAR; }
        if constexpr (FP8) asm volatile("s_nop 15\n\ts_nop 15\n\ts_nop 15\n\ts_nop 15" ::: "memory");
        if constexpr (!Epi::AFTER_DRAIN) { E(acc, cur, wr, wc, fr, fq); S.done(cur); }
        if (!has_next) break;
#pragma unroll
        for (int a = 0; a < 2; ++a)
#pragma unroll
            for (int b = 0; b < 2; ++b)
#pragma unroll
                for (int m = 0; m < 4; ++m)
#pragma unroll
                    for (int n = 0; n < 2; ++n) acc[a][b][m][n] = (f32x4){0.f, 0.f, 0.f, 0.f};
        cur = nxt; cA = nA; cB = nB; ++ui;
        if constexpr (ALIGN_EPI) { if (wr == 1) PG8_BAR; }
    }
    PG8_WAIT_V(0);
    if constexpr (!ALIGN_EPI) { if (wr == 0) PG8_BAR; }
    PG8_BAR;
    if constexpr (Epi::AFTER_DRAIN) { E.fused(acc, cur, wr, wc, fr, fq, lds, wid, lane); S.done(cur); }
#undef PG8_SA
#undef PG8_SB
#undef PG8_STAGE
#undef PG8_LDA
#undef PG8_LDB
#undef PG8_MMA
#undef PG8_WAIT_V
#undef PG8_WAIT_L
#undef PG8_BAR
#undef PG8_SCHED
}
}
#define GAS __attribute__((address_space(1)))
#define LAS __attribute__((address_space(3)))
typedef unsigned short bf16;
typedef unsigned v4u __attribute__((ext_vector_type(4)));
typedef float f32x4 __attribute__((ext_vector_type(4)));
typedef short bf16x8 __attribute__((ext_vector_type(8)));
typedef GAS unsigned gu32;
typedef GAS unsigned long long gu64;
#define RLX_AGENT __ATOMIC_RELAXED, __HIP_MEMORY_SCOPE_AGENT
#define LDS_WAIT() asm volatile("s_waitcnt lgkmcnt(0)" ::: "memory")
#define VM_WAIT() asm volatile("s_waitcnt vmcnt(0)" ::: "memory")
__device__ __forceinline__ unsigned long long rt() { return __builtin_amdgcn_s_memrealtime(); }
__device__ __forceinline__ unsigned f2bf(float f) { unsigned u = __builtin_bit_cast(unsigned, f); return (u + 0x7fffu + ((u >> 16) & 1u)) >> 16; }
__device__ __forceinline__ unsigned pk2(float lo, float hi) { return f2bf(lo) | (f2bf(hi) << 16); }

#define XB_TMO      128
#define XB_XCNT(j)  (256  + 64 * (j))
#define XB_XSUB(j)  (1280 + 64 * (j))
#define XB_XGEN(j)  (2304 + 64 * (j))
#define XB_TOP      3328
#define XB_TOPGEN   3392
#define XCD_BAR_WORDS 3456
#define XB_SPIN_CAP (1u << 18)

__device__ __forceinline__ unsigned xb_ld(unsigned* p)              { return __hip_atomic_load(p, __ATOMIC_RELAXED, __HIP_MEMORY_SCOPE_AGENT); }
__device__ __forceinline__ unsigned xb_add(unsigned* p, unsigned v) { return __hip_atomic_fetch_add(p, v, __ATOMIC_RELAXED, __HIP_MEMORY_SCOPE_AGENT); }
__device__ __forceinline__ unsigned xb_xcc_id() { return (unsigned)__builtin_amdgcn_s_getreg((3 << 11) | 20) & 0xFu; }
#define XB_SPIN(cond, bar) do { unsigned _sp = 0; while (cond) { __builtin_amdgcn_s_sleep(1); \
    if ((++_sp & 255u) == 0u) { if (xb_ld(&(bar)[XB_TMO])) break; if (_sp > XB_SPIN_CAP) { atomicAdd(&(bar)[XB_TMO], 1u); break; } } } } while (0)

struct XcdBarrier {
    unsigned* bar; unsigned x;
    volatile LAS unsigned* st;
};

__device__ __forceinline__ XcdBarrier xcd_barrier_post(unsigned* bar, volatile LAS unsigned* st) {
    XcdBarrier b; b.bar = bar; b.x = xb_xcc_id(); b.st = st;
    if (threadIdx.x == 0) (void)xb_add(&bar[XB_XCNT(b.x)], 1u);
    return b;
}
__device__ __forceinline__ void xcd_barrier_complete(unsigned* bar, unsigned x, unsigned& nloc, unsigned& nx) {
    const unsigned G = gridDim.x * gridDim.y * gridDim.z;
    unsigned sum, cnt, mine, sp = 0u;
    for (;;) {
        sum = 0u; cnt = 0u; mine = 0u;
#pragma unroll
        for (unsigned j = 0; j < 16; ++j) { const unsigned c = xb_ld(&bar[XB_XCNT(j)]); sum += c; cnt += (c > 0u) ? 1u : 0u; mine = (j == x) ? c : mine; }
        if (sum == G) break;
        __builtin_amdgcn_s_sleep(1);
        if ((++sp & 255u) == 0u) { if (xb_ld(&bar[XB_TMO])) break; if (sp > XB_SPIN_CAP) { atomicAdd(&bar[XB_TMO], 1u); break; } }
    }
    nloc = mine > 0u ? mine : 1u; nx = cnt > 0u ? cnt : 1u;
}

__device__ __forceinline__ void xcd_barrier(const XcdBarrier& b) {
    asm volatile("s_waitcnt vmcnt(0)" ::: "memory");
    __syncthreads();
    if (threadIdx.x == 0) {
        unsigned* bar = b.bar;
        __builtin_amdgcn_s_waitcnt(0);
        unsigned nloc = b.st[0], nx = b.st[1];
        if (nloc == 0u) { xcd_barrier_complete(bar, b.x, nloc, nx); b.st[0] = nloc; b.st[1] = nx; }
        const unsigned old = xb_add(&bar[XB_XSUB(b.x)], 1u);
        const unsigned gen = old / nloc;
        if (old + 1u == (gen + 1u) * nloc) {
            __builtin_amdgcn_fence(__ATOMIC_RELEASE, "agent");
            asm volatile("s_waitcnt vmcnt(0)" ::: "memory");
            const unsigned og = xb_add(&bar[XB_TOP], 1u);
            const unsigned tg = og / nx;
            if (og + 1u == (tg + 1u) * nx) xb_add(&bar[XB_TOPGEN], 1u);
            else XB_SPIN(xb_ld(&bar[XB_TOPGEN]) == tg, bar);
            __builtin_amdgcn_fence(__ATOMIC_ACQUIRE, "agent");
            xb_add(&bar[XB_XGEN(b.x)], 1u);
            asm volatile("s_waitcnt vmcnt(0)" ::: "memory");
        } else {
            XB_SPIN(xb_ld(&bar[XB_XGEN(b.x)]) == gen, bar);
            __builtin_amdgcn_fence(__ATOMIC_ACQUIRE, "agent");
            asm volatile("s_waitcnt vmcnt(0)" ::: "memory");
        }
    }
    __syncthreads();
}

constexpr int NWAVES = 8;
constexpr int NB = 2, SEQ = 4096, DM = 4096, M = NB * SEQ, NL = 2, INW = 22528, DFF = 16384;
constexpr int SSMW = 1024, NGRP = 64, NST = 64, CAW = 1536, DAW = 1536, QKVW = 9216, GTW = 12288;
constexpr int CA_H = 12, DA_H = 6, HD = 128;
constexpr float EPS = 1e-6f, LOG2E = 1.4426950408889634f, QSCALE = 0.08838834764831845f * 1.4426950408889634f;
#ifndef MK_N_LAUNCHES
#define MK_N_LAUNCHES 1
#endif
constexpr int N_PHASES = 1 + 8 * NL;
constexpr int N_LAUNCHES = MK_N_LAUNCHES;
static_assert(N_LAUNCHES == 1 || N_LAUNCHES == N_PHASES, "MK_N_LAUNCHES is 1 or 17");

constexpr size_t MiB = 1u << 20;
constexpr size_t WS_CTL = 0, CTL_ZERO_BYTES = 1 * MiB;
constexpr size_t WS_TAB = 1 * MiB, WS_SE = 5 * MiB;
constexpr size_t WS_WT = 16 * MiB, WT_IN = 0, WT_GLU = 176 * MiB, WT_OA = 178 * MiB, WT_OB = 186 * MiB, WT_OC = 198 * MiB, WT_O = 210 * MiB, WT_F1 = 242 * MiB, WT_F2 = 370 * MiB, WT_LAYER = 498 * MiB;
constexpr size_t WS_XB = WS_WT + NL * WT_LAYER;
constexpr size_t WS_UA = WS_XB + 64 * MiB, WS_QKV = WS_UA + 32 * MiB, WS_GT = WS_QKV + 144 * MiB, WS_H = WS_QKV  ;
constexpr size_t WS_Z = WS_GT + 192 * MiB, WS_YA = WS_Z + 16 * MiB, WS_YB = WS_YA + 16 * MiB, WS_YC = WS_YB + 24 * MiB, WS_MF = WS_YC + 24 * MiB, WS_MB = WS_MF + 128 * MiB;
constexpr size_t WS_X1 = WS_MB + 64 * MiB, WS_SSP = WS_X1 + 128 * MiB  , WS_XB8 = WS_SSP + 8 * MiB  , WS_END = WS_XB8 + 32 * MiB;
constexpr size_t WT_G8 = 80 * MiB;
constexpr int NQ = 10240, NGATE = 12288;
constexpr float GATE_WSCALE = 64.0f;
static_assert((size_t)INW * DM * 2 == 176 * MiB && (size_t)M * QKVW * 2 == 144 * MiB && (size_t)M * GTW * 2 == 192 * MiB && (size_t)M * DFF * 2 <= 336 * MiB, "ws map");
constexpr int TAB_A = 0, TAB_AL = 16384, TAB_LAM = 32768, TAB_G = 33024  , TAB_B = 65536;
constexpr int CW_TMO = 0, CW_CODE = 1, CW_BAR = 4096, CW_Q = 8192  , CW_SS = 16384  ;
static_assert((CW_SS + 4 * M) * 4 <= (int)CTL_ZERO_BYTES, "ctl");

constexpr int RING_OFF = 0, RING_BYTES = 131072;
constexpr int LDSCTL_OFF = RING_BYTES, MISC_OFF = LDSCTL_OFF + 320;
constexpr int EPI_TAB_OFF = 135168;
constexpr int LDS_BYTES = 147456;

static_assert(EPI_O_UA == WS_UA && EPI_O_QKV == WS_QKV && EPI_O_GT == WS_GT && EPI_O_GTAB == WS_TAB + (size_t)TAB_G * 4, "epilogue offsets vs ws map");

typedef unsigned v2u __attribute__((ext_vector_type(2)));
typedef float f32x2 __attribute__((ext_vector_type(2)));
__device__ __forceinline__ int fresh_tid() { int t = threadIdx.x; asm volatile("" : "+v"(t)); return t; }
struct Frame {
    LAS unsigned char* lds;
    volatile LAS unsigned* MISC;
    gu32* ctl;
    int wave, G;
    const float* const* in;
    unsigned char* ws;
};
__device__ __forceinline__ float wave_sum(float v) {
#pragma unroll
    for (int o = 1; o < 64; o <<= 1) v += __shfl_xor(v, o);
    return v;
}
__device__ __forceinline__ float wave_max(float v) {
#pragma unroll
    for (int o = 1; o < 64; o <<= 1) v = fmaxf(v, __shfl_xor(v, o));
    return v;
}
typedef float f32x2_cv __attribute__((ext_vector_type(2))); typedef __bf16 bf16x2_cv __attribute__((ext_vector_type(2)));
__device__ __forceinline__ unsigned cvtpk(float lo, float hi) { const f32x2_cv v = {lo, hi}; const bf16x2_cv b = __builtin_convertvector(v, bf16x2_cv); return __builtin_bit_cast(unsigned, b); }
__device__ __forceinline__ float bflo(unsigned w) { return __uint_as_float(w << 16); }
__device__ __forceinline__ float bfhi(unsigned w) { return __uint_as_float(w & 0xffff0000u); }

__device__ __forceinline__ double d_exp(double x) {
    const double k = __builtin_rint(x * 1.4426950408889634); const double r = __builtin_fma(-k, 0.6931471805599453, x) - k * 2.3190468138462996e-17;
    double s = 1.0;
#pragma unroll
    for (int i = 16; i >= 1; --i) s = 1.0 + s * r * (1.0 / (double)i);
    return s * __longlong_as_double((long long)(1023 + (int)k) << 52);
}
__device__ __forceinline__ void d_sincos(double x, double& s, double& c) {
    const double n = __builtin_rint(x * 0.6366197723675814);
    double r = __builtin_fma(-n, 1.5707963267948966, x); r = __builtin_fma(-n, 6.123233995736766e-17, r);
    const double r2 = r * r;
    double sp = -1.0 / 1307674368000.0; sp = sp * r2 + 1.0 / 6227020800.0; sp = sp * r2 - 1.0 / 39916800.0; sp = sp * r2 + 1.0 / 362880.0; sp = sp * r2 - 1.0 / 5040.0; sp = sp * r2 + 1.0 / 120.0; sp = sp * r2 - 1.0 / 6.0; sp = sp * r2 + 1.0; sp *= r;
    double cp = 1.0 / 20922789888000.0; cp = cp * r2 - 1.0 / 87178291200.0; cp = cp * r2 + 1.0 / 479001600.0; cp = cp * r2 - 1.0 / 3628800.0; cp = cp * r2 + 1.0 / 40320.0; cp = cp * r2 - 1.0 / 720.0; cp = cp * r2 + 1.0 / 24.0; cp = cp * r2 - 0.5; cp = cp * r2 + 1.0;
    const int q = ((int)n) & 3;
    s = (q == 0) ? sp : (q == 1) ? cp : (q == 2) ? -sp : -cp;
    c = (q == 0) ? cp : (q == 1) ? -sp : (q == 2) ? -cp : sp;
}

#define TR_LOAD(it_) do { const int g_ = (it_) >> 3, kq_ = g_ / nblk, nb_ = g_ - kq_ * nblk, kb_ = kq_ * 8 + ((it_) & 7); \
        _Pragma("unroll") for (int i = 0; i < 16; ++i) { const int k = kb_ * 64 + 8 * (i >> 1) + 2 * r + (i & 1); v[i] = *(const GAS f32x4*)(W + (size_t)k * ldw + nb_ * 64 + 4 * c4); } \
        if (gain) { _Pragma("unroll") for (int i = 0; i < 16; ++i) gv[i] = gain[kb_ * 64 + 8 * (i >> 1) + 2 * r + (i & 1)]; } } while (0)
__device__ __forceinline__ void tr_range(const Frame& F, const float* W, int K, int N, int ldw, const float* gain, bf16* WT, int it0, int NGW, int nitems) {
    LAS unsigned* scr = (LAS unsigned*)(F.lds + RING_OFF + F.wave * 8192);
    const int gw = it0, nblk = N >> 6;
    const int lane = fresh_tid() & 63, r = lane >> 4, c4 = lane & 15;
    f32x4 v[16]; float gv[16];
    int it = gw;
    if (it < nitems) TR_LOAD(it);
    while (it < nitems) {
        const int g = it >> 3, kq = g / nblk, nb = g - kq * nblk, kb = kq * 8 + (it & 7), k0 = kb * 64, n0 = nb * 64;
        if (gain) {
#pragma unroll
            for (int i = 0; i < 16; ++i) v[i] = v[i] * gv[i];
        }
#pragma unroll
        for (int a = 0; a < 8; ++a)
#pragma unroll
            for (int j = 0; j < 4; ++j) scr[(4 * c4 + j) * 32 + 4 * (a ^ (c4 & 7)) + r] = cvtpk(v[2 * a][j], v[2 * a + 1][j]);
        const int nx = it + NGW;
        if (nx < nitems) TR_LOAD(nx);
        LDS_WAIT(); asm volatile("" ::: "memory");
#pragma unroll
        for (int jj = 0; jj < 8; ++jj) { const int idx = lane + 64 * jj, n = idx >> 3, c = idx & 7;
            const v4u o = *(const LAS v4u*)(scr + n * 32 + 4 * (c ^ ((n >> 2) & 7)));
            *(GAS v4u*)(WT + (size_t)(n0 + n) * K + k0 + 8 * c) = o; }
        LDS_WAIT(); asm volatile("" ::: "memory");
        it = nx;
    }
}
#undef TR_LOAD
__device__ __forceinline__ unsigned pack_fp8x4(float a, float b, float c, float d) { int w = 0; w = __builtin_amdgcn_cvt_pk_fp8_f32(a, b, w, false); w = __builtin_amdgcn_cvt_pk_fp8_f32(c, d, w, true); return (unsigned)w; }
#define TR_LOAD8(it_) do { const int g_ = (it_) >> 3, kq_ = g_ / nblk, nb_ = g_ - kq_ * nblk, kb_ = kq_ * 8 + ((it_) & 7); \
        _Pragma("unroll") for (int i = 0; i < 16; ++i) { const int k = kb_ * 64 + 16 * (i >> 2) + 4 * r + (i & 3); v[i] = *(const GAS f32x4*)(W + (size_t)k * ldw + nb_ * 64 + 4 * c4); } \
        _Pragma("unroll") for (int i = 0; i < 16; ++i) gv[i] = gain[kb_ * 64 + 16 * (i >> 2) + 4 * r + (i & 3)]; } while (0)
__device__ __forceinline__ void tr_range8(const Frame& F, const float* W, int K, int N, int ldw, const float* gain, float scale, unsigned char* WT, int it0, int NGW, int nitems) {
    LAS unsigned* scr = (LAS unsigned*)(F.lds + RING_OFF + F.wave * 8192);
    const int gw = it0, nblk = N >> 6;
    const int lane = fresh_tid() & 63, r = lane >> 4, c4 = lane & 15;
    f32x4 v[16]; float gv[16];
    int it = gw;
    if (it < nitems) TR_LOAD8(it);
    while (it < nitems) {
        const int g = it >> 3, kq = g / nblk, nb = g - kq * nblk, kb = kq * 8 + (it & 7), k0 = kb * 64, n0 = nb * 64;
#pragma unroll
        for (int i = 0; i < 16; ++i) v[i] = v[i] * (gv[i] * scale);
#pragma unroll
        for (int a = 0; a < 4; ++a)
#pragma unroll
            for (int j = 0; j < 4; ++j) scr[(4 * c4 + j) * 16 + 4 * (a ^ (c4 & 3)) + r] = pack_fp8x4(v[4 * a][j], v[4 * a + 1][j], v[4 * a + 2][j], v[4 * a + 3][j]);
        const int nx = it + NGW;
        if (nx < nitems) TR_LOAD8(nx);
        LDS_WAIT(); asm volatile("" ::: "memory");
#pragma unroll
        for (int jj = 0; jj < 4; ++jj) { const int idx = lane + 64 * jj, n = idx >> 2, c = idx & 3;
            const v4u o = *(const LAS v4u*)(scr + n * 16 + 4 * (c ^ ((n >> 2) & 3)));
            *(GAS v4u*)(WT + (size_t)(n0 + n) * K + k0 + 16 * c) = o; }
        LDS_WAIT(); asm volatile("" ::: "memory");
        it = nx;
    }
}
#undef TR_LOAD8

struct Args { const float* in[30]; float* out; unsigned char* ws; int ph_lo, ph_hi, li, pad; };
typedef const __attribute__((address_space(4))) Args* KArgs;
enum { I_X = 0, I_NORM_MIX, I_W_IN, I_A_RE, I_A_IM, I_LOG_DT, I_B_RE, I_B_IM, I_C_RE, I_C_IM, I_SSM_D, I_W_GLU, I_B_GLU, I_CA_QG, I_CA_KG, I_CA_BIAS, I_DA_QG, I_DA_KG,
       I_LQ1, I_LK1, I_LQ2, I_LK2, I_SUBLN, I_W_OA, I_W_OB, I_W_OC, I_W_O, I_NORM_MLP, I_W_FF1, I_W_FF2 };
__device__ __forceinline__ float lambda_init_of(int l) { return l == 0 ? 0.2f : 0.35550906759096926f; }

constexpr int CONV_REST = 644, CONV_WIN = 352;
__device__ __forceinline__ void conv_chunk(const Frame& F, KArgs A, int L, int c) {
    const float* W; int K, N, ldw, cc = c, Lw = L; const float* gain = nullptr; size_t wto; bool f8 = false;
    if (c < 4)        { W = A->in[I_W_GLU] + (size_t)L * SSMW * SSMW; K = SSMW; N = SSMW; ldw = SSMW; wto = WT_GLU; }
    else if (c < 20)  { cc = c - 4;   W = A->in[I_W_OA] + (size_t)L * SSMW * DM; K = SSMW; N = DM; ldw = DM; wto = WT_OA; }
    else if (c < 44)  { cc = c - 20;  W = A->in[I_W_OB] + (size_t)L * CAW * DM; K = CAW; N = DM; ldw = DM; wto = WT_OB; }
    else if (c < 68)  { cc = c - 44;  W = A->in[I_W_OC] + (size_t)L * DAW * DM; K = DAW; N = DM; ldw = DM; wto = WT_OC; }
    else if (c < 132) { cc = c - 68;  W = A->in[I_W_O] + (size_t)L * DM * DM; K = DM; N = DM; ldw = DM; wto = WT_O; }
    else if (c < 388) { cc = c - 132; W = A->in[I_W_FF1] + (size_t)L * DM * DFF; K = DM; N = DFF; ldw = DFF; gain = A->in[I_NORM_MLP] + L * DM; wto = WT_F1; }
    else if (c < 644) { cc = c - 388; W = A->in[I_W_FF2] + (size_t)L * DFF * DM; K = DFF; N = DM; ldw = DM; wto = WT_F2; }
    else if (c < 804) { cc = c - 644; Lw = L + 1; W = A->in[I_W_IN] + (size_t)Lw * DM * INW; K = DM; N = NQ; ldw = INW; gain = A->in[I_NORM_MIX] + Lw * DM; wto = WT_IN; }
    else              { cc = c - 804; Lw = L + 1; W = A->in[I_W_IN] + (size_t)Lw * DM * INW + NQ; K = DM; N = NGATE; ldw = INW; gain = A->in[I_NORM_MIX] + Lw * DM; wto = WT_IN + WT_G8; f8 = true; }
    unsigned char* wt = A->ws + WS_WT + (size_t)Lw * WT_LAYER + wto;
    if (f8) tr_range8(F, W, K, N, ldw, gain, GATE_WSCALE, wt, cc * 64 + F.wave, 8, cc * 64 + 64);
    else tr_range(F, W, K, N, ldw, gain, (bf16*)wt, cc * 64 + F.wave, 8, cc * 64 + 64);
}

__device__ __forceinline__ void p0_prologue(const Frame& F, KArgs A) {
    unsigned char* ws = A->ws;
    {
        unsigned char* wl = ws + WS_WT;
        const int gw = blockIdx.x * NWAVES + F.wave, NGW = F.G * NWAVES;
        tr_range(F, A->in[I_W_IN], DM, NQ, INW, A->in[I_NORM_MIX], (bf16*)(wl + WT_IN), gw, NGW, (DM >> 6) * (NQ >> 6));
        tr_range8(F, A->in[I_W_IN] + NQ, DM, NGATE, INW, A->in[I_NORM_MIX], GATE_WSCALE, wl + WT_IN + WT_G8, gw, NGW, (DM >> 6) * (NGATE >> 6));
    }
    {
        const int gw = blockIdx.x * NWAVES + F.wave, NGW = F.G * NWAVES;
        float* ssp = (float*)(ws + WS_SSP);
        for (int m = gw; m < M; m += NGW) {
            const GAS f32x4* xr = (const GAS f32x4*)(A->in[I_X] + (size_t)m * DM) + (fresh_tid() & 63); GAS v2u* o = (GAS v2u*)((bf16*)(ws + WS_XB) + (size_t)m * DM) + (fresh_tid() & 63); float s = 0.f;
            GAS unsigned* o8 = (GAS unsigned*)(ws + WS_XB8 + (size_t)m * DM) + (fresh_tid() & 63);
            f32x4 v[16];
#pragma unroll
            for (int j = 0; j < 16; ++j) v[j] = xr[64 * j];
#pragma unroll
            for (int j = 0; j < 16; ++j) { s += (v[j].x * v[j].x + v[j].y * v[j].y) + (v[j].z * v[j].z + v[j].w * v[j].w); v2u w; w.x = cvtpk(v[j].x, v[j].y); w.y = cvtpk(v[j].z, v[j].w); o[64 * j] = w; o8[64 * j] = pack_fp8x4(v[j].x, v[j].y, v[j].z, v[j].w); }
            s = wave_sum(s); ssp[(size_t)m * 64 + (fresh_tid() & 63)] = ((fresh_tid() & 63) == 0) ? s : 0.f;
        }
    }
    {
        float* tab = (float*)(ws + WS_TAB);
        const int gt = blockIdx.x * (NWAVES * 64) + fresh_tid();
        if (gt < NL * NGRP * NST) {
            const int l = gt / (NGRP * NST), g = (gt / NST) % NGRP, p = gt % NST;
            const double lr = (double)fminf(A->in[I_A_RE][gt], -1e-4f), li = (double)A->in[I_A_IM][gt];
            const double dt = d_exp((double)A->in[I_LOG_DT][l * NGRP + g]);
            double e = d_exp(lr * dt), sn, cs; d_sincos(li * dt, sn, cs);
            const double ar = e * cs, ai = e * sn;
            tab[TAB_A + 2 * gt] = (float)ar; tab[TAB_A + 2 * gt + 1] = (float)ai;
            e = d_exp(lr * dt * 64.0); d_sincos(li * dt * 64.0, sn, cs);
            tab[TAB_AL + 2 * gt] = (float)(e * cs); tab[TAB_AL + 2 * gt + 1] = (float)(e * sn);
            const double nr = ar - 1.0, ni = ai, den = lr * lr + li * li, fr = (nr * lr + ni * li) / den, fi = (ni * lr - nr * li) / den;
#pragma unroll 4
            for (int h = 0; h < 16; ++h) { const double br = (double)A->in[I_B_RE][(size_t)gt * 16 + h], bi = (double)A->in[I_B_IM][(size_t)gt * 16 + h];
                tab[TAB_B + ((size_t)gt * 16 + h) * 2] = (float)(fr * br - fi * bi); tab[TAB_B + ((size_t)gt * 16 + h) * 2 + 1] = (float)(fr * bi + fi * br); }
        }
        if (gt < NL * 4 * HD) { const int ll = gt / (4 * HD), k = (gt / HD) & 3, d = gt % HD;
            tab[TAB_G + gt] = A->in[k == 0 ? I_CA_QG : k == 1 ? I_CA_KG : k == 2 ? I_DA_QG : I_DA_KG][ll * HD + d] * ((k & 1) ? 1.0f : QSCALE); }
        if (gt < NL) {
            double s1 = 0.0, s2 = 0.0;
            for (int i = 0; i < HD; ++i) { s1 += (double)A->in[I_LQ1][gt * HD + i] * (double)A->in[I_LK1][gt * HD + i]; s2 += (double)A->in[I_LQ2][gt * HD + i] * (double)A->in[I_LK2][gt * HD + i]; }
            tab[TAB_LAM + gt] = (float)(d_exp(s1) - d_exp(s2) + (double)lambda_init_of(gt));
        }
    }
}

__device__ __forceinline__ float gelu_tanh(float y) { const float t = 0.7978845608028654f * (y + 0.044715f * y * y * y); const float e = __expf(2.0f * t); return 0.5f * y * (2.0f - 2.0f / (e + 1.0f)); }

__device__ __forceinline__ int q_pop(const Frame& F, gu32* head) {
    __syncthreads();
    if (fresh_tid() == 0) F.MISC[0] = __hip_atomic_fetch_add(head, 1u, RLX_AGENT);
    __syncthreads();
    return (int)F.MISC[0];
}

constexpr int SSM_UNITS = NB * NGRP * 8;
typedef float f32x16s __attribute__((ext_vector_type(16)));
__device__ __forceinline__ void split8(const f32x4 a, const f32x4 b, bf16x8& hi, bf16x8& lo) {
    v4u h, l2; h.x = cvtpk(a[0], a[1]); h.y = cvtpk(a[2], a[3]); h.z = cvtpk(b[0], b[1]); h.w = cvtpk(b[2], b[3]);
    l2.x = cvtpk(a[0] - bflo(h.x), a[1] - bfhi(h.x)); l2.y = cvtpk(a[2] - bflo(h.y), a[3] - bfhi(h.y)); l2.z = cvtpk(b[0] - bflo(h.z), b[1] - bfhi(h.z)); l2.w = cvtpk(b[2] - bflo(h.w), b[3] - bfhi(h.w));
    hi = *reinterpret_cast<bf16x8*>(&h); lo = *reinterpret_cast<bf16x8*>(&l2);
}
struct SsmB { bf16x8 h[4], l[4]; float ar0, ai0, ar1, ai1; };
__device__ __forceinline__ void ssm_load_b(SsmB& Bf, const float* tab, int l, int g, int lane) {
    const int c = lane & 31, hk = lane >> 5;
#pragma unroll
    for (int st = 0; st < 2; ++st) { const int gi = (l * NGRP + g) * NST + st * 32 + c; const float* bp = tab + TAB_B + ((size_t)gi * 16 + 8 * hk) * 2;
        const f32x4 v0 = *(const GAS f32x4*)bp, v1 = *(const GAS f32x4*)(bp + 4), v2 = *(const GAS f32x4*)(bp + 8), v3 = *(const GAS f32x4*)(bp + 12);
        split8((f32x4){v0[0], v0[2], v1[0], v1[2]}, (f32x4){v2[0], v2[2], v3[0], v3[2]}, Bf.h[2 * st], Bf.l[2 * st]);
        split8((f32x4){v0[1], v0[3], v1[1], v1[3]}, (f32x4){v2[1], v2[3], v3[1], v3[3]}, Bf.h[2 * st + 1], Bf.l[2 * st + 1]);
        const float ar = tab[TAB_A + 2 * gi], ai = tab[TAB_A + 2 * gi + 1]; if (st == 0) { Bf.ar0 = ar; Bf.ai0 = ai; } else { Bf.ar1 = ar; Bf.ai1 = ai; } }
}
struct SsmU { f32x4 a, b; };
__device__ __forceinline__ SsmU ssm_ld_u(const float* UA, size_t tok0, int g, int lane) {
    const int R = lane & 31, hk = lane >> 5, tau = 16 * ((R >> 2) & 1) + (R & 3) + 4 * (R >> 3);
    const float* up = UA + (tok0 + tau) * SSMW + g * 16 + 8 * hk;
    SsmU u; u.a = *(const GAS f32x4*)up; u.b = *(const GAS f32x4*)(up + 4); return u;
}
__device__ __forceinline__ void ssm_bu32(f32x16s (&acc)[4], const SsmB& Bf, const SsmU& u) {
    bf16x8 uh, ul; split8(u.a, u.b, uh, ul);
#pragma unroll
    for (int cb = 0; cb < 4; ++cb) { f32x16s a = {};
        a = __builtin_amdgcn_mfma_f32_32x32x16_bf16(ul, Bf.h[cb], a, 0, 0, 0); a = __builtin_amdgcn_mfma_f32_32x32x16_bf16(uh, Bf.l[cb], a, 0, 0, 0); a = __builtin_amdgcn_mfma_f32_32x32x16_bf16(uh, Bf.h[cb], a, 0, 0, 0);
        acc[cb] = a; }
    asm volatile("" :: "v"(uh), "v"(ul));
}
__device__ __forceinline__ void ssm_stage_a(const Frame& F, KArgs A, int l) {
    int lane_ = fresh_tid(); const int lane = lane_ & 63, c32 = lane & 31;
    const float* tab = (const float*)(A->ws + WS_TAB); const float* UA = (const float*)(A->ws + WS_UA); float* SE = (float*)(A->ws + WS_SE);
    for (int un = blockIdx.x; un < SSM_UNITS; un += F.G) {
        const int span = un & 7, bg = un >> 3, b = bg / NGRP, g = bg % NGRP, c = span * 8 + F.wave;
        SsmB Bf; ssm_load_b(Bf, tab, l, g, lane);
        float x0r = 0.f, x0i = 0.f, x1r = 0.f, x1i = 0.f;
        const SsmU u0 = ssm_ld_u(UA, (size_t)b * SEQ + c * 64, g, lane), u1 = ssm_ld_u(UA, (size_t)b * SEQ + c * 64 + 32, g, lane);
#pragma unroll 1
        for (int rb = 0; rb < 2; ++rb) {
            f32x16s acc[4]; ssm_bu32(acc, Bf, rb ? u1 : u0);
#pragma unroll
            for (int ph = 0; ph < 2; ++ph) {
                if (ph == 1) { x0r = __shfl(x0r, c32); x0i = __shfl(x0i, c32); x1r = __shfl(x1r, c32); x1i = __shfl(x1i, c32); }
#pragma unroll
                for (int r = 0; r < 16; ++r) { const float n0r = Bf.ar0 * x0r - Bf.ai0 * x0i + acc[0][r], n0i = Bf.ar0 * x0i + Bf.ai0 * x0r + acc[1][r]; x0r = n0r; x0i = n0i;
                    const float n1r = Bf.ar1 * x1r - Bf.ai1 * x1i + acc[2][r], n1i = Bf.ar1 * x1i + Bf.ai1 * x1r + acc[3][r]; x1r = n1r; x1i = n1i; }
            }
            x0r = __shfl(x0r, 32 + c32); x0i = __shfl(x0i, 32 + c32); x1r = __shfl(x1r, 32 + c32); x1i = __shfl(x1i, 32 + c32);
        }
        if (lane < 32) { float* ep = SE + ((size_t)(bg * 64 + c) * NST) * 2; *(GAS f32x2*)(ep + 2 * c32) = (f32x2){x0r, x0i}; *(GAS f32x2*)(ep + 2 * (32 + c32)) = (f32x2){x1r, x1i}; }
    }
}
__device__ __forceinline__ void ssm_stage_c(const Frame& F, KArgs A, int l, int un) {
    int lane_ = fresh_tid(); const int lane = lane_ & 63, c32 = lane & 31, hi = lane >> 5, t16 = lane & 15, kk = lane >> 4;
    const float* tab = (const float*)(A->ws + WS_TAB); const float* UA = (const float*)(A->ws + WS_UA); const float* SE = (const float*)(A->ws + WS_SE); bf16* Z = (bf16*)(A->ws + WS_Z);
    LAS unsigned char* xs = F.lds + RING_OFF + F.wave * 9216;
    const int span = un & 7, bg = un >> 3, b = bg / NGRP, g = bg % NGRP, c = span * 8 + F.wave;
    bf16x8 Ch[4], Cl[4];
    { const float* cre = A->in[I_C_RE] + (size_t)(l * NGRP + g) * 16 * NST + t16 * NST; const float* cim = A->in[I_C_IM] + (size_t)(l * NGRP + g) * 16 * NST + t16 * NST;
#pragma unroll
      for (int s4 = 0; s4 < 4; ++s4) { const f32x4 re = *(const f32x4*)(cre + 16 * s4 + 4 * kk), im = *(const f32x4*)(cim + 16 * s4 + 4 * kk);
          split8((f32x4){re[0], -im[0], re[1], -im[1]}, (f32x4){re[2], -im[2], re[3], -im[3]}, Ch[s4], Cl[s4]); } }
    SsmB Bf; ssm_load_b(Bf, tab, l, g, lane);
    const SsmU u0 = ssm_ld_u(UA, (size_t)b * SEQ + c * 64, g, lane), u1 = ssm_ld_u(UA, (size_t)b * SEQ + c * 64 + 32, g, lane);
    float xr = 0.f, xi = 0.f;
    { const int gi = (l * NGRP + g) * NST + lane; const float alr = tab[TAB_AL + 2 * gi], ali = tab[TAB_AL + 2 * gi + 1];
      const GAS f32x2* ep = (const GAS f32x2*)(SE + ((size_t)(bg * 64) * NST + lane) * 2); float pr = 1.f, pi = 0.f;
      for (int bt = 0; bt < 2; ++bt) { if (bt * 32 < c) {
        f32x2 e[32];
#pragma unroll
        for (int j = 0; j < 32; ++j) { const int cc = c - 1 - (bt * 32 + j); e[j] = ep[(size_t)(cc > 0 ? cc : 0) * NST]; if (cc < 0) e[j] = (f32x2){0.f, 0.f}; }
#pragma unroll
        for (int j = 0; j < 32; ++j) { xr += pr * e[j][0] - pi * e[j][1]; xi += pr * e[j][1] + pi * e[j][0]; const float nr = pr * alr - pi * ali, ni = pr * ali + pi * alr; pr = nr; pi = ni; } } } }
    float x0r = __shfl(xr, c32), x0i = __shfl(xi, c32), x1r = __shfl(xr, 32 + c32), x1i = __shfl(xi, 32 + c32);
    const float dsk = A->in[I_SSM_D][l * SSMW + g * 16 + t16];
#pragma unroll 1
    for (int rb = 0; rb < 2; ++rb) {
        const size_t tok0 = (size_t)b * SEQ + c * 64 + rb * 32;
        f32x16s acc[4]; ssm_bu32(acc, Bf, rb ? u1 : u0);
#pragma unroll
        for (int ph = 0; ph < 2; ++ph) {
            if (ph == 1) { x0r = __shfl(x0r, c32); x0i = __shfl(x0i, c32); x1r = __shfl(x1r, c32); x1i = __shfl(x1i, c32); }
#pragma unroll
            for (int r = 0; r < 16; ++r) { const float n0r = Bf.ar0 * x0r - Bf.ai0 * x0i + acc[0][r], n0i = Bf.ar0 * x0i + Bf.ai0 * x0r + acc[1][r]; x0r = n0r; x0i = n0i;
                const float n1r = Bf.ar1 * x1r - Bf.ai1 * x1i + acc[2][r], n1i = Bf.ar1 * x1i + Bf.ai1 * x1r + acc[3][r]; x1r = n1r; x1i = n1i;
                const int row = (hi == ph) ? (16 * ph + r) : 32;
                *(LAS unsigned*)(xs + row * 272 + 4 * c32) = cvtpk(x0r, x0i); *(LAS unsigned*)(xs + row * 272 + 4 * (32 + c32)) = cvtpk(x1r, x1i); }
        }
        x0r = __shfl(x0r, 32 + c32); x0i = __shfl(x0i, 32 + c32); x1r = __shfl(x1r, 32 + c32); x1i = __shfl(x1i, 32 + c32);
        LDS_WAIT(); asm volatile("" ::: "memory");
#pragma unroll
        for (int tt = 0; tt < 2; ++tt) {
            f32x4 y = {0.f, 0.f, 0.f, 0.f};
#pragma unroll
            for (int s4 = 0; s4 < 4; ++s4) { const bf16x8 xa = *(const LAS bf16x8*)(xs + (16 * tt + t16) * 272 + (32 * s4 + 8 * kk) * 2);
                y = __builtin_amdgcn_mfma_f32_16x16x32_bf16(xa, Cl[s4], y, 0, 0, 0); y = __builtin_amdgcn_mfma_f32_16x16x32_bf16(xa, Ch[s4], y, 0, 0, 0); asm volatile("" :: "v"(xa)); }
#pragma unroll
            for (int r = 0; r < 4; ++r) { const size_t tok = tok0 + 16 * tt + 4 * kk + r; const float z = gelu_tanh(y[r] + dsk * UA[tok * SSMW + g * 16 + t16]);
                Z[tok * SSMW + g * 16 + t16] = (bf16)(cvtpk(z, z) & 0xffffu); }
        }
        LDS_WAIT(); asm volatile("" ::: "memory");
    }
}

namespace att {
using f32x16 = __attribute__((ext_vector_type(16))) float;
using s16x4 = __attribute__((ext_vector_type(4))) short;
#define KSWZ(row, colB) ((row) * 256 + ((colB) ^ (((row) & 7) << 4)))
#define SBAR() __builtin_amdgcn_sched_barrier(0)
__device__ __forceinline__ int crow(int r, int hi) { return (r & 3) + 8 * (r >> 2) + 4 * hi; }
__device__ __forceinline__ void qkt(f32x16& p0, f32x16& p1, const LAS char* Ks, const bf16x8* qr, int r32, int hi) {
    bf16x8 fa, fb;
    { const int cb = (hi * 8) * 2; fa = *(const LAS bf16x8*)(Ks + KSWZ(r32, cb)); fb = *(const LAS bf16x8*)(Ks + KSWZ(32 + r32, cb)); }
#pragma unroll
    for (int d0 = 0; d0 < 8; ++d0) {
        const bf16x8 b0 = fa, b1 = fb;
        if (d0 + 1 < 8) { const int cb = ((d0 + 1) * 16 + hi * 8) * 2; fa = *(const LAS bf16x8*)(Ks + KSWZ(r32, cb)); fb = *(const LAS bf16x8*)(Ks + KSWZ(32 + r32, cb)); }
        p0 = __builtin_amdgcn_mfma_f32_32x32x16_bf16(b0, qr[d0], p0, 0, 0, 0); p1 = __builtin_amdgcn_mfma_f32_32x32x16_bf16(b1, qr[d0], p1, 0, 0, 0);
        SBAR();
    }
}
__device__ __forceinline__ int v_st(int k, int c) { const int kk = (k & ~0xC) | ((k & 4) << 1) | ((k & 8) >> 1); return ((kk >> 3) * 4 + (c >> 5)) * 512 + ((kk & 7) * 32 + (c & 31)) * 2; }
__device__ __forceinline__ int v_rd_base(int lane) { return ((lane & 3) << 3) | (((lane >> 2) & 3) << 6) | (((lane >> 4) & 1) << 5) | (((lane >> 5) & 1) << 8); }
constexpr int v_rd_off(int d0, int ks, int half) { return d0 * 512 + ks * 4096 + half * 2048; }
template <int OFF> __device__ __forceinline__ s16x4 tr_read(int vb) { s16x4 r; asm volatile("ds_read_b64_tr_b16 %0, %1 offset:%2" : "=&v"(r) : "v"(vb), "i"(OFF) : "memory"); return r; }
template <int D0> __device__ __forceinline__ void pv_one(f32x16& od, int vb, bf16x8 pa0, bf16x8 pa1, bf16x8 pa2, bf16x8 pa3) {
    const s16x4 l0 = tr_read<v_rd_off(D0, 0, 0)>(vb), h0 = tr_read<v_rd_off(D0, 0, 1)>(vb), l1 = tr_read<v_rd_off(D0, 1, 0)>(vb), h1 = tr_read<v_rd_off(D0, 1, 1)>(vb);
    const s16x4 l2 = tr_read<v_rd_off(D0, 2, 0)>(vb), h2 = tr_read<v_rd_off(D0, 2, 1)>(vb), l3 = tr_read<v_rd_off(D0, 3, 0)>(vb), h3 = tr_read<v_rd_off(D0, 3, 1)>(vb);
    asm volatile("s_waitcnt lgkmcnt(0)" ::: "memory"); SBAR();
#define PK(L, H) (bf16x8){L[0], L[1], L[2], L[3], H[0], H[1], H[2], H[3]}
    od = __builtin_amdgcn_mfma_f32_32x32x16_bf16(pa0, PK(l0, h0), od, 0, 0, 0);
    od = __builtin_amdgcn_mfma_f32_32x32x16_bf16(pa1, PK(l1, h1), od, 0, 0, 0);
    od = __builtin_amdgcn_mfma_f32_32x32x16_bf16(pa2, PK(l2, h2), od, 0, 0, 0);
    od = __builtin_amdgcn_mfma_f32_32x32x16_bf16(pa3, PK(l3, h3), od, 0, 0, 0);
#undef PK
}
template <int NV>
__device__ __forceinline__ void tile_step(f32x16& p0, f32x16& p1, f32x16 (&o)[NV], float& m_reg, float& l_reg, const LAS char* Ks, int vb, const bf16x8* qr, LAS float* al, int r32, int hi) {
    qkt(p0, p1, Ks, qr, r32, hi);
    float pmax = p0[0];
#pragma unroll
    for (int r = 1; r < 16; ++r) pmax = fmaxf(pmax, p0[r]);
#pragma unroll
    for (int r = 0; r < 16; ++r) pmax = fmaxf(pmax, p1[r]);
    { auto rr = __builtin_amdgcn_permlane32_swap(__float_as_uint(pmax), __float_as_uint(pmax), false, false); pmax = fmaxf(__uint_as_float(rr[0]), __uint_as_float(rr[1])); }
    const float mn = fmaxf(m_reg, pmax), alpha = __builtin_amdgcn_exp2f(m_reg - mn); m_reg = mn;
    float ps = 0.f;
#pragma unroll
    for (int r = 0; r < 16; ++r) { p0[r] = __builtin_amdgcn_exp2f(p0[r] - mn); ps += p0[r]; }
#pragma unroll
    for (int r = 0; r < 16; ++r) { p1[r] = __builtin_amdgcn_exp2f(p1[r] - mn); ps += p1[r]; }
    { auto rr = __builtin_amdgcn_permlane32_swap(__float_as_uint(ps), __float_as_uint(ps), false, false); ps = __uint_as_float(rr[0]) + __uint_as_float(rr[1]); }
    l_reg = l_reg * alpha + ps;
    if (__any(alpha < 1.f)) { if (hi == 0) al[r32] = alpha; asm volatile("s_waitcnt lgkmcnt(0)" ::: "memory");
#pragma unroll
        for (int d = 0; d < NV; ++d)
#pragma unroll
            for (int r = 0; r < 16; ++r) o[d][r] *= al[crow(r, hi)]; }
    bf16x8 pa0, pa1, pa2, pa3;
#define PK4(P, BASE, OUT) do { unsigned a0 = cvtpk(P[BASE + 0], P[BASE + 1]), a1 = cvtpk(P[BASE + 2], P[BASE + 3]); unsigned b0 = cvtpk(P[BASE + 4], P[BASE + 5]), b1 = cvtpk(P[BASE + 6], P[BASE + 7]); \
    auto r0 = __builtin_amdgcn_permlane32_swap(a0, b0, false, false); auto r1 = __builtin_amdgcn_permlane32_swap(a1, b1, false, false); v4u w = {r0[0], r1[0], r0[1], r1[1]}; OUT = *reinterpret_cast<bf16x8*>(&w); } while (0)
    PK4(p0, 0, pa0); PK4(p0, 8, pa1); PK4(p1, 0, pa2); PK4(p1, 8, pa3);
#undef PK4
    SBAR();
    pv_one<0>(o[0], vb, pa0, pa1, pa2, pa3); pv_one<1>(o[1], vb, pa0, pa1, pa2, pa3); pv_one<2>(o[2], vb, pa0, pa1, pa2, pa3); pv_one<3>(o[3], vb, pa0, pa1, pa2, pa3);
    if constexpr (NV == 8) { pv_one<32>(o[4], vb, pa0, pa1, pa2, pa3); pv_one<33>(o[5], vb, pa0, pa1, pa2, pa3); pv_one<34>(o[6], vb, pa0, pa1, pa2, pa3); pv_one<35>(o[7], vb, pa0, pa1, pa2, pa3); }
}

constexpr int BAND_UNITS = NB * CA_H * (SEQ / 256);
constexpr int ATT_AL_OFF = 132096;
__device__ __forceinline__ void band_unit(const Frame& F, KArgs A, int l, int un) {
    int tid_ = fresh_tid(); asm volatile("" : "+v"(tid_)); const int tid = tid_, lane = tid & 63, r32 = lane & 31, hi = lane >> 5, wid = F.wave;
    const int qb = 15 - un / (NB * CA_H), rem = un % (NB * CA_H), b = rem / CA_H, h = rem % CA_H;
    const bf16* QKV = (const bf16*)(A->ws + WS_QKV); bf16* YB = (bf16*)(A->ws + WS_YB);
    LAS char* Kb = (LAS char*)(F.lds + RING_OFF);
    LAS float* bt = (LAS float*)(F.lds + EPI_TAB_OFF); LAS float* al = (LAS float*)(F.lds + ATT_AL_OFF) + wid * 64;
    const size_t rowb = (size_t)b * SEQ;
    { const float* rb = A->in[I_CA_BIAS] + (size_t)(l * CA_H + h) * 257;
      for (int i = tid; i < 640; i += 512) { int rel = i - 63; rel = rel > 128 ? 128 : rel; bt[i] = rb[rel + 128] * LOG2E; } }
    bf16x8 qr[8];
    { const bf16* Qw = QKV + (rowb + qb * 256 + wid * 32 + r32) * QKVW + h * HD + hi * 8;
#pragma unroll
      for (int d0 = 0; d0 < 8; ++d0) qr[d0] = *(const GAS bf16x8*)(Qw + d0 * 16); }
    const int t_lo = (4 * qb - 8) > 0 ? (4 * qb - 8) : 0, t_hi = 4 * qb + 3, cw = 4 * qb + (wid >> 1);
    const int vb0 = (int)(uintptr_t)(Kb + 16384) + v_rd_base(lane);
    const int img = wid >> 2, part = wid & 3;
    unsigned voff[2];
    { const int row8 = (lane >> 2) & 7;
      const unsigned vl = (unsigned)((8 * (row8 >> 2) + (row8 & 3)) * QKVW * 2 + (hi * 32 + (lane & 3) * 8) * 2);
#pragma unroll
      for (int i1 = 0; i1 < 2; ++i1) voff[i1] = img == 0 ? (unsigned)((lane >> 4) * QKVW * 2 + ((lane & 15) ^ (i1 * 4 + (lane >> 4))) * 16) : vl; }
    const char* gsrc = (const char*)(QKV + rowb * QKVW + (img == 0 ? 1536 : 3072) + h * HD) + (size_t)(part * 16) * QKVW * 2;
    LAS unsigned char* dst0 = (LAS unsigned char*)Kb + img * 16384 + part * 4096;
#define DMAT(t, bo) do { const char* gs_ = gsrc + (size_t)(t) * 64 * QKVW * 2; _Pragma("unroll") for (int i_ = 0; i_ < 4; ++i_) { \
        const size_t ub_ = img == 0 ? (size_t)(4 * i_) * QKVW * 2 : (size_t)(((i_ >> 1) & 1) * 4) * QKVW * 2 + (i_ & 1) * 128; \
        __builtin_amdgcn_global_load_lds((const unsigned*)(gs_ + ub_ + voff[i_ & 1]), (LAS unsigned*)(dst0 + (bo) + i_ * 1024), 16, 0, 0); } } while (0)
    DMAT(t_lo, 0); if (t_lo + 1 <= t_hi) DMAT(t_lo + 1, 32768); if (t_lo + 2 <= t_hi) DMAT(t_lo + 2, 65536);
    float m_reg = -1e30f, l_reg = 0.f; f32x16 o[4] = {};
    for (int t = t_lo; t <= t_hi; ++t) {
        const int cur = ((t - t_lo) & 3) * 32768, rem = t_hi - t;
        if (rem >= 2) asm volatile("s_waitcnt vmcnt(8)" ::: "memory"); else if (rem == 1) asm volatile("s_waitcnt vmcnt(4)" ::: "memory"); else asm volatile("s_waitcnt vmcnt(0)" ::: "memory");
        asm volatile("s_waitcnt lgkmcnt(0)" ::: "memory"); __builtin_amdgcn_s_barrier(); asm volatile("" ::: "memory");
        if (t + 3 <= t_hi) DMAT(t + 3, ((t + 3 - t_lo) & 3) * 32768);
        if (t >= cw - 8 && t <= cw) {
            const int base = qb * 256 + wid * 32 + r32 + 63 - 4 * hi - 64 * t;
            f32x16 p0, p1;
#pragma unroll
            for (int r = 0; r < 16; ++r) { const int cr = (r & 3) + 8 * (r >> 2); p0[r] = bt[base - cr]; p1[r] = bt[base - cr - 32]; }
            tile_step<4>(p0, p1, o, m_reg, l_reg, Kb + cur, vb0 + cur, qr, al, r32, hi);
        }
    }
#undef DMAT
    if (hi == 0) al[r32] = l_reg; asm volatile("s_waitcnt lgkmcnt(0)" ::: "memory");
    bf16* Ow = YB + (rowb + qb * 256 + wid * 32) * CAW + h * HD;
#pragma unroll
    for (int r = 0; r < 16; ++r) { const int orow = crow(r, hi); const float rl = __builtin_amdgcn_rcpf(al[orow]);
#pragma unroll
        for (int d0 = 0; d0 < 4; ++d0) Ow[(size_t)orow * CAW + d0 * 32 + r32] = (bf16)(cvtpk(o[d0][r] * rl, 0.f) & 0xffffu); }
}

constexpr int DIFF_UNITS = NB * DA_H * (SEQ / 128);
__device__ __forceinline__ void diff_unit(const Frame& F, KArgs A, int l, int un) {
    int tid_ = fresh_tid(); asm volatile("" : "+v"(tid_)); const int tid = tid_, lane = tid & 63, r32 = lane & 31, hi = lane >> 5, wid = F.wave;
    const int jb = 31 - un / (NB * DA_H), rem = un % (NB * DA_H), b = rem / DA_H, h = rem % DA_H;
    const int rg = wid & 3, mp = wid >> 2, cw = 2 * jb + (rg >> 1), t_hi = 2 * jb + 1;
    const bf16* QKV = (const bf16*)(A->ws + WS_QKV); bf16* YC = (bf16*)(A->ws + WS_YC);
    LAS char* Kb = (LAS char*)(F.lds + RING_OFF);
    LAS float* al = (LAS float*)(F.lds + ATT_AL_OFF) + wid * 64;
    const size_t rowb = (size_t)b * SEQ;
    const float slope2 = exp2f(-8.0f * (float)(h + 1) / (float)DA_H) * LOG2E;
    bf16x8 qr[8];
    { const bf16* Qw = QKV + (rowb + jb * 128 + rg * 32 + r32) * QKVW + 4608 + h * 256 + mp * HD + hi * 8;
#pragma unroll
      for (int d0 = 0; d0 < 8; ++d0) qr[d0] = *(const GAS bf16x8*)(Qw + d0 * 16); }
    const LAS char* Ks = Kb + mp * 16384; const int vb0 = (int)(uintptr_t)(Kb + 32768) + v_rd_base(lane);
    const int img = wid >> 1, part = wid & 1;
    unsigned voff[2];
    { const int row8 = (lane >> 2) & 7;
      const unsigned vl = (unsigned)((8 * (row8 >> 2) + (row8 & 3)) * QKVW * 2 + (hi * 32 + (lane & 3) * 8) * 2);
#pragma unroll
      for (int i1 = 0; i1 < 2; ++i1) voff[i1] = img < 2 ? (unsigned)((lane >> 4) * QKVW * 2 + ((lane & 15) ^ (i1 * 4 + (lane >> 4))) * 16) : vl; }
    const char* gsrc = (const char*)(QKV + rowb * QKVW + (img < 2 ? 6144 : 7680) + h * 256 + (img & 1) * 128) + (size_t)(part * 32) * QKVW * 2;
    LAS unsigned char* dst0 = (LAS unsigned char*)Kb + img * 16384 + part * 8192;
#define DMAT(t, bo) do { const char* gs_ = gsrc + (size_t)(t) * 64 * QKVW * 2; _Pragma("unroll") for (int i_ = 0; i_ < 8; ++i_) { \
        const size_t ub_ = img < 2 ? (size_t)(4 * i_) * QKVW * 2 : (size_t)((i_ >> 2) * 16 + ((i_ >> 1) & 1) * 4) * QKVW * 2 + (i_ & 1) * 128; \
        __builtin_amdgcn_global_load_lds((const unsigned*)(gs_ + ub_ + voff[i_ & 1]), (LAS unsigned*)(dst0 + (bo) + i_ * 1024), 16, 0, 0); } } while (0)
    DMAT(t_hi, 0);
    float m_reg = -1e30f, l_reg = 0.f; f32x16 o[8] = {};
    asm volatile("s_waitcnt vmcnt(0)" ::: "memory"); __syncthreads();
    for (int st = 0; st <= t_hi; ++st) {
        const int t = t_hi - st, cur = (st & 1) * 65536;
        if (t > 0) DMAT(t - 1, cur ^ 65536);
        if (t <= cw) {
            const float basef = (float)(64 * (cw - t) + (rg & 1) * 32 + r32 - 4 * hi);
            f32x16 p0, p1;
            if (t == cw) {
#pragma unroll
                for (int r = 0; r < 16; ++r) { const float cr = (float)((r & 3) + 8 * (r >> 2)); p0[r] = -slope2 * fabsf(basef - cr); p1[r] = -slope2 * fabsf(basef - cr - 32.f); }
            } else {
                const float nb = -slope2 * basef;
#pragma unroll
                for (int r = 0; r < 16; ++r) { const float cr = (float)((r & 3) + 8 * (r >> 2)); p0[r] = fmaf(slope2, cr, nb); p1[r] = fmaf(slope2, cr + 32.f, nb); }
            }
            tile_step<8>(p0, p1, o, m_reg, l_reg, Ks + cur, vb0 + cur, qr, al, r32, hi);
        }
        asm volatile("s_waitcnt vmcnt(0)" ::: "memory"); __syncthreads();
    }
#undef DMAT
    if (hi == 0) al[r32] = l_reg; asm volatile("s_waitcnt lgkmcnt(0)" ::: "memory");
#pragma unroll
    for (int r = 0; r < 16; ++r) { const float rl = __builtin_amdgcn_rcpf(al[crow(r, hi)]);
#pragma unroll
        for (int d0 = 0; d0 < 8; ++d0) o[d0][r] *= rl; }
    LAS float* X = (LAS float*)(F.lds + RING_OFF) + rg * (32 * 132);
    const float lam = ((const float*)(A->ws + WS_TAB))[TAB_LAM + l];
    const int erow = lane >> 1, eh = lane & 1;
    f32x4 val[2][16]; float sq = 0.f;
#pragma unroll
    for (int hf = 0; hf < 2; ++hf) {
        if (mp == 1) {
#pragma unroll
            for (int r = 0; r < 16; ++r)
#pragma unroll
                for (int d0 = 0; d0 < 4; ++d0) X[crow(r, hi) * 132 + d0 * 32 + r32] = o[4 * hf + d0][r];
        }
        __syncthreads();
        if (mp == 0) {
#pragma unroll
            for (int r = 0; r < 16; ++r)
#pragma unroll
                for (int d0 = 0; d0 < 4; ++d0) { LAS float* xp = X + crow(r, hi) * 132 + d0 * 32 + r32; *xp = o[4 * hf + d0][r] - lam * *xp; }
            asm volatile("s_waitcnt lgkmcnt(0)" ::: "memory");
#pragma unroll
            for (int j = 0; j < 16; ++j) { val[hf][j] = *(const LAS f32x4*)(X + erow * 132 + eh * 64 + 4 * j); sq += (val[hf][j][0] * val[hf][j][0] + val[hf][j][1] * val[hf][j][1]) + (val[hf][j][2] * val[hf][j][2] + val[hf][j][3] * val[hf][j][3]); }
        }
        __syncthreads();
    }
    if (mp == 0) {
        sq += __shfl_xor(sq, 1);
        int ll = l; asm volatile("" : "+s"(ll));
        const float rr = rsqrtf(sq * (1.0f / 256.0f) + EPS) * (1.0f - lambda_init_of(ll));
#pragma unroll
        for (int hf = 0; hf < 2; ++hf) {
            const float* gn = A->in[I_SUBLN] + l * 256 + hf * 128 + eh * 64;
            bf16* op = YC + (rowb + jb * 128 + rg * 32 + erow) * DAW + h * 256 + hf * 128 + eh * 64;
#pragma unroll
            for (int j = 0; j < 16; j += 2) { const f32x4 g0 = *(const f32x4*)(gn + 4 * j), g1 = *(const f32x4*)(gn + 4 * j + 4);
                v4u w; w.x = cvtpk(val[hf][j][0] * rr * g0[0], val[hf][j][1] * rr * g0[1]); w.y = cvtpk(val[hf][j][2] * rr * g0[2], val[hf][j][3] * rr * g0[3]);
                w.z = cvtpk(val[hf][j + 1][0] * rr * g1[0], val[hf][j + 1][1] * rr * g1[1]); w.w = cvtpk(val[hf][j + 1][2] * rr * g1[2], val[hf][j + 1][3] * rr * g1[3]);
                *(GAS v4u*)(op + 4 * j) = w; }
        }
    }
}
#undef KSWZ
#undef SBAR
}

__global__ void __launch_bounds__(NWAVES * 64, 2) mk_fwd(Args args) {
    extern __shared__ __attribute__((aligned(16))) unsigned char lds[];
    Frame F;
    F.lds = (LAS unsigned char*)lds;
    F.MISC = (volatile LAS unsigned*)(F.lds + MISC_OFF);
    F.wave = __builtin_amdgcn_readfirstlane(fresh_tid() >> 6);
    F.G = gridDim.x; F.in = nullptr; F.ws = args.ws;
    unsigned char* ws = args.ws;
    F.ctl = (gu32*)(ws + WS_CTL);
    for (int u = fresh_tid(); u < (LDS_BYTES - LDSCTL_OFF) / 4; u += NWAVES * 64) ((LAS unsigned*)(F.lds + LDSCTL_OFF))[u] = 0u;
    __syncthreads();
    XcdBarrier bar; bar.bar = (unsigned*)(F.ctl + CW_BAR); bar.x = 0; bar.st = nullptr;
    if (N_LAUNCHES == 1) bar = xcd_barrier_post((unsigned*)(F.ctl + CW_BAR), F.MISC + 8);
#define GRID_BAR() do { if (N_LAUNCHES != 1) { if (fresh_tid() == 0) __hip_atomic_store(F.ctl + CW_TMO, 0xBADBA0u, RLX_AGENT); } else { xcd_barrier(bar); } } while (0)
    const KArgs kap = (KArgs)__builtin_amdgcn_kernarg_segment_ptr();
#define LARGS(name) KArgs name##_p = kap; asm volatile("" : "+s"(name##_p)); KArgs name = name##_p
    const int lo = args.ph_lo, hi = args.ph_hi;
#define IN(k) (lo <= (k) && (k) < hi)
#define BOTH(k) (IN(k) && IN((k) + 1))

    if (IN(0)) { LARGS(A0); p0_prologue(F, A0); if (BOTH(0)) GRID_BAR(); }

    for (int l = 0; l < NL; ++l) {
        const int pb = 1 + 8 * l;
#define PHASE_ENV() LARGS(A); int lp = l; asm volatile("" : "+s"(lp)); int bx = (int)blockIdx.x; asm volatile("" : "+s"(bx)); (void)bx; unsigned char* ws = A->ws; unsigned char* wl = ws + WS_WT + (size_t)lp * WT_LAYER; \
        float* ssb = (float*)(ws + WS_SSP); float* ss_in = ssb + (size_t)lp * M * 64; float* ss_mid = ssb + (size_t)(NL + lp) * M * 64; float* ss_next = (lp + 1 < NL) ? ssb + (size_t)(lp + 1) * M * 64 : nullptr; \
        pg8::bf16_t* XB = (pg8::bf16_t*)(ws + WS_XB); float* X1 = (float*)(ws + WS_X1); (void)wl; (void)ss_in; (void)ss_mid; (void)ss_next; (void)XB; (void)X1

#define ROW_SCALES(ssp_, S_) pg8::Unit u0_; u0_.pm = 0; u0_.pn = 0; (void)(S_).next(0, u0_); { LAS float* rt_ = (LAS float*)(F.lds + EPI_TAB_OFF); const int t_ = fresh_tid(); \
            if (t_ < 256) rt_[t_] = pg8::rms_from_slots(ssp_, u0_.pm * 256 + t_); \
            rt_[2304 + t_] = ((const float*)(ws + WS_TAB))[TAB_G + lp * 512 + t_];   } LDS_WAIT(); __syncthreads(); \
        const pg8::RowScale rs_{ssp_, (const LAS float*)(F.lds + EPI_TAB_OFF), u0_.pm}
        if (IN(pb + 0)) {
            PHASE_ENV();
            pg8::Gemm g{XB, (const pg8::bf16_t*)(wl + WT_IN), M, NQ, DM}; pg8::InterleavedOrder S; S.init(M, NQ, F.G, bx);
            ROW_SCALES(ss_in, S);
            (void)rs_; pg8::EpiIn E{ws, F.lds + EPI_TAB_OFF, lp};
            pg8::gemm_phase<pg8::EpiIn, pg8::InterleavedOrder, true, true>(F.lds + RING_OFF, g, S, E);
            pg8::Gemm g8{(const pg8::bf16_t*)(ws + WS_XB8), (const pg8::bf16_t*)(wl + WT_IN + WT_G8), M, NGATE, DM / 2}; pg8::StaticOrder S8; S8.init(M, NGATE, F.G, bx);
            pg8::EpiGate E8{(const LAS float*)(F.lds + EPI_TAB_OFF), ws + WS_GT, 1.0f / GATE_WSCALE};
            pg8::gemm_phase<pg8::EpiGate, pg8::StaticOrder, true, true, true>(F.lds + RING_OFF, g8, S8, E8);
            if (BOTH(pb + 0)) GRID_BAR();
        }
        if (IN(pb + 1)) {
            PHASE_ENV();
            ssm_stage_a(F, A, lp);
            if (BOTH(pb + 1)) GRID_BAR();
        }
        if (IN(pb + 2)) {
            PHASE_ENV();
            gu32* qh = F.ctl + CW_Q + 64 * (lp * 4);
            const int nconv = CONV_REST + ((lp + 1 < NL) ? CONV_WIN : 0);
#ifndef CONV_MASK
#define CONV_MASK 1
#endif
            if (((bx >> 3) & CONV_MASK) == 0) for (;;) { const int c = q_pop(F, qh + 192); if (c >= nconv) break; conv_chunk(F, A, lp, c); }
            for (;;) { const int un = q_pop(F, qh); if (un >= att::DIFF_UNITS) break; att::diff_unit(F, A, lp, un); }
            for (;;) { const int un = q_pop(F, qh + 64); if (un >= att::BAND_UNITS) break; att::band_unit(F, A, lp, un); }
            for (;;) { const int un = q_pop(F, qh + 128); if (un >= SSM_UNITS) break; ssm_stage_c(F, A, lp, un); }
            for (;;) { const int c = q_pop(F, qh + 192); if (c >= nconv) break; conv_chunk(F, A, lp, c); }
            if (BOTH(pb + 2)) GRID_BAR();
        }
        if (IN(pb + 3)) {
            PHASE_ENV();
            pg8::Gemm g{(const pg8::bf16_t*)(ws + WS_Z), (const pg8::bf16_t*)(wl + WT_GLU), M, SSMW, SSMW}; pg8::StaticOrder S; S.init(M, SSMW, F.G, bx);
            pg8::EpiGlu E{(const pg8::bf16_t*)(ws + WS_Z), A->in[I_B_GLU] + lp * SSMW, (pg8::bf16_t*)(ws + WS_YA)};
            pg8::gemm_phase<pg8::EpiGlu, pg8::StaticOrder, true, true>(F.lds + RING_OFF, g, S, E);
            if (BOTH(pb + 3)) GRID_BAR();
        }
        if (IN(pb + 4)) {
            PHASE_ENV();
            const unsigned char* GT = ws + WS_GT; pg8::bf16_t* MF = (pg8::bf16_t*)(ws + WS_MF); pg8::bf16_t* MB = (pg8::bf16_t*)(ws + WS_MB);
            pg8::StaticOrder S; S.init(M, DM, F.G, bx);
            { pg8::Gemm g{(const pg8::bf16_t*)(ws + WS_YA), (const pg8::bf16_t*)(wl + WT_OA), M, DM, SSMW}; pg8::EpiMerge<0> E{GT, 0, MF, MB};
              pg8::gemm_phase<pg8::EpiMerge<0>, pg8::StaticOrder, true, true>(F.lds + RING_OFF, g, S, E); }
            { pg8::Gemm g{(const pg8::bf16_t*)(ws + WS_YB), (const pg8::bf16_t*)(wl + WT_OB), M, DM, CAW}; pg8::EpiMerge<1> E{GT, DM, MF, MB};
              pg8::gemm_phase<pg8::EpiMerge<1>, pg8::StaticOrder, true, true>(F.lds + RING_OFF, g, S, E); }
            { pg8::Gemm g{(const pg8::bf16_t*)(ws + WS_YC), (const pg8::bf16_t*)(wl + WT_OC), M, DM, DAW}; pg8::EpiMerge<2> E{GT, 2 * DM, MF, MB};
              pg8::gemm_phase<pg8::EpiMerge<2>, pg8::StaticOrder, true, true>(F.lds + RING_OFF, g, S, E); }
            if (BOTH(pb + 4)) GRID_BAR();
        }
        if (IN(pb + 5)) {
            PHASE_ENV();
            pg8::Gemm g{(const pg8::bf16_t*)(ws + WS_MB), (const pg8::bf16_t*)(wl + WT_O), M, DM, DM}; pg8::StaticOrder S; S.init(M, DM, F.G, bx);
            const float* xin = (lp == 0) ? A->in[I_X] : (const float*)A->out;
            pg8::EpiRes E{xin, X1, XB, ss_mid, nullptr};
            pg8::gemm_phase<pg8::EpiRes, pg8::StaticOrder, true, true>(F.lds + RING_OFF, g, S, E);
            if (BOTH(pb + 5)) GRID_BAR();
        }
        if (IN(pb + 6)) {
            PHASE_ENV();
            pg8::Gemm g{XB, (const pg8::bf16_t*)(wl + WT_F1), M, DFF, DM}; pg8::StaticOrder S; S.init(M, DFF, F.G, bx);
            ROW_SCALES(ss_mid, S);
            pg8::EpiFf1 E{rs_, (pg8::bf16_t*)(ws + WS_H)};
            pg8::gemm_phase<pg8::EpiFf1, pg8::StaticOrder, true, true>(F.lds + RING_OFF, g, S, E);
            if (BOTH(pb + 6)) GRID_BAR();
        }
        if (IN(pb + 7)) {
            PHASE_ENV();
            pg8::Gemm g{(const pg8::bf16_t*)(ws + WS_H), (const pg8::bf16_t*)(wl + WT_F2), M, DM, DFF}; pg8::StaticOrder S; S.init(M, DM, F.G, bx);
            pg8::EpiRes E{X1, A->out, (lp + 1 < NL) ? XB : nullptr, ss_next, (lp + 1 < NL) ? ws + WS_XB8 : nullptr};
            pg8::gemm_phase<pg8::EpiRes, pg8::StaticOrder, true, true>(F.lds + RING_OFF, g, S, E);
            if (BOTH(pb + 7)) GRID_BAR();
        }
    }
#undef IN
#undef BOTH
}

extern "C" void kernel_launch(void* const* d_in, const int* in_sizes, int n_in, void* d_out, int out_size, void* d_ws, size_t ws_size, hipStream_t stream) {
    static int grid = 0;
    if (grid == 0) {
        if (n_in != 30 || in_sizes[0] != M * DM || out_size != M * DM || ws_size < WS_END) {
            fprintf(stderr, "kernel_launch: built for 30 inputs, x/out of %d floats, >= %zu bytes of workspace; got n_in %d, in0 %d, out %d, ws %zu; nothing launched\n", M * DM, (size_t)WS_END, n_in, n_in > 0 ? in_sizes[0] : -1, out_size, ws_size);
            grid = -1; return; }
        int dev = 0, cus = 0, per_cu = 0;
        if (hipGetDevice(&dev) != hipSuccess || hipDeviceGetAttribute(&cus, hipDeviceAttributeMultiprocessorCount, dev) != hipSuccess) { fprintf(stderr, "kernel_launch: device query failed\n"); grid = -1; return; }
        if (hipFuncSetAttribute((const void*)mk_fwd, hipFuncAttributeMaxDynamicSharedMemorySize, LDS_BYTES) != hipSuccess) { fprintf(stderr, "kernel_launch: hipFuncSetAttribute failed\n"); grid = -1; return; }
        if (hipOccupancyMaxActiveBlocksPerMultiprocessor(&per_cu, (const void*)mk_fwd, NWAVES * 64, LDS_BYTES) != hipSuccess || per_cu < 1)
            fprintf(stderr, "kernel_launch: note: occupancy query reports %d workgroups per CU\n", per_cu);
        (void)hipGetLastError();
        grid = cus;
        if (grid != 256) { fprintf(stderr, "kernel_launch: built for a 256-CU device (unit deal and row-panel tables assume 256 workgroups); found %d CUs; nothing launched\n", cus); grid = -1; return; }
    }
    if (grid < 0) return;
    if (hipMemsetAsync((char*)d_ws + WS_CTL, 0, CTL_ZERO_BYTES, stream) != hipSuccess) { fprintf(stderr, "kernel_launch: memset failed\n"); return; }
    Args a{};
    for (int i = 0; i < 30; ++i) a.in[i] = (const float*)d_in[i];
    a.out = (float*)d_out; a.ws = (unsigned char*)d_ws;
    for (int li = 0; li < N_LAUNCHES; ++li) {
        a.ph_lo = (N_LAUNCHES == 1) ? 0 : li; a.ph_hi = (N_LAUNCHES == 1) ? N_PHASES : li + 1; a.li = li; a.pad = 0;
        hipLaunchKernelGGL(mk_fwd, dim3(grid), dim3(NWAVES * 64), LDS_BYTES, stream, a);
        const hipError_t le = hipPeekAtLastError();
        if (le != hipSuccess) { fprintf(stderr, "kernel_launch: launch %d failed: %s\n", li, hipGetErrorName(le)); break; }
    }
}
```

```cpp
#include <hip/hip_runtime.h>
#include <cstdio>
#include <cstdint>
#define EPI_O_UA   ((size_t)1076 << 20)
#define EPI_O_QKV  ((size_t)1108 << 20)
#define EPI_O_GT   ((size_t)1252 << 20)
#define EPI_O_GTAB (((size_t)1 << 20) + 33024 * 4)
namespace pg8 {
#define PG8_LAS __attribute__((address_space(3)))
typedef unsigned short bf16_t;
typedef short bf16x8 __attribute__((ext_vector_type(8)));
typedef float f32x4 __attribute__((ext_vector_type(4)));
typedef unsigned u32x4 __attribute__((ext_vector_type(4)));
constexpr int BM = 256, BK = 64, HALF = 128, HTB = HALF * BK * 2  , STAGE_BYTES = 8 * HTB, NXCD = 8, WGM = 8;

__host__ __device__ __forceinline__ int lds_byte(int r, int c) { const int st = (r >> 4) * 2 + (c >> 5), rr = r & 15, cc = c & 31, ob = rr * 64 + cc * 2; return st * 1024 + (ob ^ (((ob >> 9) & 1) << 5)); }
__host__ __device__ __forceinline__ void stage_rc(int b, int& R, int& C) { const int st = b / 1024, sb = b % 1024, swz = sb ^ (((sb >> 9) & 1) << 5); R = (st >> 1) * 16 + swz / 64; C = (st & 1) * 32 + (swz % 64) / 2; }
__host__ __device__ __forceinline__ int perm32(int rho) { const int n = rho >> 4, i = rho & 15; return 8 * (i >> 2) + 4 * n + (i & 3); }

struct Unit { int pm, pn; };
struct Gemm { const bf16_t* A; const bf16_t* Bt; int M, N, K; };

struct StaticOrder {
    int nM, nN, nwg, G, c;
    __host__ __device__ void init(int M, int N, int G_, int c_) { nM = M / BM; nN = N / BM; nwg = nM * nN; G = G_; c = c_; }
    __host__ __device__ bool next(int i, Unit& u) const {
        const long L = (long)i * G + c; if (L >= nwg) return false;
        int wgid = (int)L; { const int q = nwg / NXCD, r = nwg % NXCD, xcd = wgid % NXCD, off = wgid / NXCD; wgid = (xcd < r ? xcd * (q + 1) : r * (q + 1) + (xcd - r) * q) + off; }
        const int nig = WGM * nN, gid = wgid / nig, fm = gid * WGM, gsz = (nM - fm) < WGM ? (nM - fm) : WGM;
        u.pm = fm + ((wgid % nig) % gsz); u.pn = (wgid % nig) / gsz; return true;
    }
    __device__ __forceinline__ void a_ready(const Unit&) const {}
    __device__ __forceinline__ void done(const Unit&) const {}
};

struct InterleavedOrder : StaticOrder {
    __host__ __device__ bool next(int i, Unit& u) const { if (!StaticOrder::next(i, u)) return false; const int half = nN >> 1; u.pn = (u.pn % half) * 2 + u.pn / half; return true; }
};
typedef float f32x2_cv __attribute__((ext_vector_type(2))); typedef __bf16 bf16x2_cv __attribute__((ext_vector_type(2)));
__device__ __forceinline__ unsigned cvt_pk_bf16(float lo, float hi) { const f32x2_cv v = {lo, hi}; const bf16x2_cv b = __builtin_convertvector(v, bf16x2_cv); return __builtin_bit_cast(unsigned, b); }
typedef float f32x2 __attribute__((ext_vector_type(2)));
__device__ __forceinline__ u32x4 pack8(f32x4 v0, f32x4 v1) { u32x4 w; w.x = cvt_pk_bf16(v0[0], v0[1]); w.y = cvt_pk_bf16(v0[2], v0[3]); w.z = cvt_pk_bf16(v1[0], v1[1]); w.w = cvt_pk_bf16(v1[2], v1[3]); return w; }
__device__ __forceinline__ void unpack8(u32x4 w, f32x4& v0, f32x4& v1) {
    v0[0] = __uint_as_float(w.x << 16); v0[1] = __uint_as_float(w.x & 0xffff0000u); v0[2] = __uint_as_float(w.y << 16); v0[3] = __uint_as_float(w.y & 0xffff0000u);
    v1[0] = __uint_as_float(w.z << 16); v1[1] = __uint_as_float(w.z & 0xffff0000u); v1[2] = __uint_as_float(w.w << 16); v1[3] = __uint_as_float(w.w & 0xffff0000u); }
__device__ __forceinline__ float sigm(float x) { return __builtin_amdgcn_rcpf(1.0f + __builtin_amdgcn_exp2f(-1.4426950408889634f * x)); }
__device__ __forceinline__ f32x4 sigm4(f32x4 v) { f32x4 o; o[0] = sigm(v[0]); o[1] = sigm(v[1]); o[2] = sigm(v[2]); o[3] = sigm(v[3]); return o; }

__device__ __forceinline__ float rms_from_slots(const float* ssp, int row) {
    const f32x4* p = (const f32x4*)(ssp + (size_t)row * 64); float s = 0.f;
#pragma unroll
    for (int i = 0; i < 16; ++i) { const f32x4 v = p[i]; s += (v[0] + v[1]) + (v[2] + v[3]); }
    return rsqrtf(s * (1.0f / 4096.0f) + 1e-6f);
}
struct RowScale { const float* ssp; PG8_LAS const float* rtab; int pm0;
    __device__ __forceinline__ float get(int pm, int rloc) const { (void)pm; return rtab[rloc]; } };
struct EpiIn {
    static constexpr bool PERM = true, AFTER_DRAIN = false;
    unsigned char* ws; PG8_LAS unsigned char* ldsb; int layer;
    static constexpr size_t O_UA = EPI_O_UA, O_QKV = EPI_O_QKV, O_GT = EPI_O_GT, O_GTAB = EPI_O_GTAB;
    __device__ __forceinline__ void operator()(const f32x4 (&acc)[2][2][4][2], const Unit& u, int wr, int wc, int fr, int fq) const {
        float* UA = (float*)(ws + O_UA); bf16_t* QKV = (bf16_t*)(ws + O_QKV); bf16_t* GT = (bf16_t*)(ws + O_GT);
        const RowScale rs{nullptr, (PG8_LAS const float*)ldsb, 0}; PG8_LAS float* ptab = (PG8_LAS float*)(ldsb + 1024);
        const int row0 = u.pm * BM + wr * 64 + fr, colt = u.pn * BM, cin = wc * 32 + 8 * fq;
        const int sec = (colt - 1024) / 1536;
        const bool qk = colt >= 1024 && colt < 10240 && sec != 2 && sec != 5;
        if (qk) {
#pragma unroll
            for (int ai = 0; ai < 2; ++ai)
#pragma unroll
                for (int m = 0; m < 4; ++m) { const int rloc = ai * HALF + wr * 64 + m * 16 + fr; const float r = rs.get(u.pm, rloc);
#pragma unroll
                    for (int bj = 0; bj < 2; ++bj) { const f32x4 v0 = acc[ai][bj][m][0] * r, v1 = acc[ai][bj][m][1] * r;
                        float q = (v0[0] * v0[0] + v0[1] * v0[1]) + (v0[2] * v0[2] + v0[3] * v0[3]) + (v1[0] * v1[0] + v1[1] * v1[1]) + (v1[2] * v1[2] + v1[3] * v1[3]);
                        q += __shfl_xor(q, 16); q += __shfl_xor(q, 32);
                        if (fq == 0) ptab[(rloc * 2 + bj) * 4 + wc] = q; } }
            asm volatile("s_waitcnt lgkmcnt(0)" ::: "memory"); __builtin_amdgcn_s_barrier(); asm volatile("" ::: "memory");
            int cin2 = cin; asm volatile("" : "+v"(cin2));
            PG8_LAS const float* gp = (PG8_LAS const float*)(ldsb + 9216) + (sec - (sec >= 3 ? 1 : 0)) * 128 + cin2;
            const f32x4 g0 = *(PG8_LAS const f32x4*)gp, g1 = *(PG8_LAS const f32x4*)(gp + 4);
#pragma unroll
            for (int ai = 0; ai < 2; ++ai)
#pragma unroll
                for (int m = 0; m < 4; ++m) { const int rloc = ai * HALF + wr * 64 + m * 16 + fr; const int row = u.pm * BM + rloc; const float r = rs.get(u.pm, rloc);
#pragma unroll
                    for (int bj = 0; bj < 2; ++bj) { const f32x4 pq = *(const PG8_LAS f32x4*)(ptab + (rloc * 2 + bj) * 4);
                        const float rr = r * rsqrtf(((pq[0] + pq[1]) + (pq[2] + pq[3])) * (1.0f / 128.0f) + 1e-6f);
                        *(u32x4*)(QKV + (size_t)row * 9216 + (colt - 1024) + cin + bj * HALF) = pack8(acc[ai][bj][m][0] * rr * g0, acc[ai][bj][m][1] * rr * g1); }
                    asm volatile("" ::: "memory"); }
            return;
        }
#pragma unroll
        for (int ai = 0; ai < 2; ++ai)
#pragma unroll
            for (int m = 0; m < 4; ++m) { const int row = row0 + ai * HALF + m * 16; const float r = rs.get(u.pm, ai * HALF + wr * 64 + m * 16 + fr);
#pragma unroll
                for (int bj = 0; bj < 2; ++bj) { f32x4 v0 = acc[ai][bj][m][0] * r, v1 = acc[ai][bj][m][1] * r; const int c = cin + bj * HALF;
                    if (colt < 1024) { float* p = UA + (size_t)row * 1024 + colt + c; *(f32x4*)p = v0; *(f32x4*)(p + 4) = v1; }
                    else if (colt < 10240) { *(u32x4*)(QKV + (size_t)row * 9216 + (colt - 1024) + c) = pack8(v0, v1); }
                    else { *(u32x4*)(GT + (size_t)row * 12288 + (colt - 10240) + c) = pack8(sigm4(v0), sigm4(v1)); } }
                asm volatile("" ::: "memory"); }
    }
};
__device__ __forceinline__ unsigned q8x4(f32x4 g) { const unsigned a = (unsigned)(g[0] * 255.0f + 0.5f), b = (unsigned)(g[1] * 255.0f + 0.5f), c = (unsigned)(g[2] * 255.0f + 0.5f), d = (unsigned)(g[3] * 255.0f + 0.5f);
    return a | (b << 8) | (c << 16) | (d << 24); }
__device__ __forceinline__ f32x4 dq8x4(unsigned w) { f32x4 o; o[0] = (float)(w & 0xffu); o[1] = (float)((w >> 8) & 0xffu); o[2] = (float)((w >> 16) & 0xffu); o[3] = (float)(w >> 24); return o * (1.0f / 255.0f); }
struct EpiGate {
    static constexpr bool PERM = true, AFTER_DRAIN = false;
    PG8_LAS const float* rtab; unsigned char* GT; float inv_wscale;
    __device__ __forceinline__ void operator()(const f32x4 (&acc)[2][2][4][2], const Unit& u, int wr, int wc, int fr, int fq) const {
        const int row0 = u.pm * BM + wr * 64 + fr, cb = u.pn * BM + wc * 64 + fq * 16;
#pragma unroll
        for (int ai = 0; ai < 2; ++ai)
#pragma unroll
            for (int m = 0; m < 4; ++m) { const int row = row0 + ai * HALF + m * 16; const float r = rtab[ai * HALF + wr * 64 + m * 16 + fr] * inv_wscale;
                u32x4 w; w.x = q8x4(sigm4(acc[ai][0][m][0] * r)); w.y = q8x4(sigm4(acc[ai][0][m][1] * r)); w.z = q8x4(sigm4(acc[ai][1][m][0] * r)); w.w = q8x4(sigm4(acc[ai][1][m][1] * r));
                *(u32x4*)(GT + (size_t)row * 12288 + cb) = w;
                asm volatile("" ::: "memory"); }
    }
};
struct EpiGlu {
    static constexpr bool PERM = true, AFTER_DRAIN = false;
    const bf16_t* Z; const float* bias; bf16_t* YA;
    __device__ __forceinline__ void operator()(const f32x4 (&acc)[2][2][4][2], const Unit& u, int wr, int wc, int fr, int fq) const {
        const int row0 = u.pm * BM + wr * 64 + fr, col0 = u.pn * BM + wc * 32 + 8 * fq;
        f32x4 bv[2][2];
#pragma unroll
        for (int bj = 0; bj < 2; ++bj)
#pragma unroll
            for (int n = 0; n < 2; ++n) bv[bj][n] = *(const f32x4*)(bias + col0 + bj * HALF + 4 * n);
        u32x4 zr[4][2];
#define EG_LOAD(g_) do { const size_t o_ = (size_t)(row0 + ((g_) >> 2) * HALF + ((g_) & 3) * 16) * 1024 + col0; zr[(g_) & 3][0] = *(const u32x4*)(Z + o_); zr[(g_) & 3][1] = *(const u32x4*)(Z + o_ + HALF); } while (0)
        EG_LOAD(0); EG_LOAD(1); EG_LOAD(2);
#pragma unroll
        for (int g = 0; g < 8; ++g) { const int ai = g >> 2, m = g & 3; const size_t off = (size_t)(row0 + ai * HALF + m * 16) * 1024 + col0;
            const u32x4 zw0 = zr[g & 3][0], zw1 = zr[g & 3][1];
            if (g + 3 < 8) EG_LOAD(g + 3);
#pragma unroll
            for (int bj = 0; bj < 2; ++bj) { f32x4 z0, z1; unpack8(bj ? zw1 : zw0, z0, z1);
                const f32x4 v0 = z0 * sigm4(acc[ai][bj][m][0] + bv[bj][0]), v1 = z1 * sigm4(acc[ai][bj][m][1] + bv[bj][1]);
                *(u32x4*)(YA + off + bj * HALF) = pack8(v0, v1); }
            asm volatile("" ::: "memory"); }
#undef EG_LOAD
    }
};
template <int MODE> struct EpiMerge {
    static constexpr bool PERM = true, AFTER_DRAIN = false;
    const unsigned char* GT; int goff; bf16_t* MS; bf16_t* MB;
    __device__ __forceinline__ void operator()(const f32x4 (&acc)[2][2][4][2], const Unit& u, int wr, int wc, int fr, int fq) const {
        const int row0 = u.pm * BM + wr * 64 + fr, col0 = u.pn * BM + wc * 32 + 8 * fq, cb = goff + u.pn * BM + wc * 64 + fq * 16;
        u32x4 gwr[4], msr[4][2];
#define EM_LOAD(g_) do { const int row_ = row0 + ((g_) >> 2) * HALF + ((g_) & 3) * 16; gwr[(g_) & 3] = *(const u32x4*)(GT + (size_t)row_ * 12288 + cb); \
            if (MODE >= 1) { msr[(g_) & 3][0] = *(const u32x4*)(MS + (size_t)row_ * 4096 + col0); msr[(g_) & 3][1] = *(const u32x4*)(MS + (size_t)row_ * 4096 + col0 + HALF); } } while (0)
        EM_LOAD(0); EM_LOAD(1); EM_LOAD(2);
#pragma unroll
        for (int g = 0; g < 8; ++g) { const int ai = g >> 2, m = g & 3, row = row0 + ai * HALF + m * 16; const size_t off = (size_t)row * 4096 + col0;
            const u32x4 gw = gwr[g & 3]; const u32x4 m0 = msr[g & 3][0], m1 = msr[g & 3][1];
            if (g + 3 < 8) EM_LOAD(g + 3);
#pragma unroll
            for (int bj = 0; bj < 2; ++bj) { const f32x4 g0 = dq8x4(bj ? gw.z : gw.x), g1 = dq8x4(bj ? gw.w : gw.y);
                f32x4 v0 = g0 * acc[ai][bj][m][0], v1 = g1 * acc[ai][bj][m][1];
                if (MODE >= 1) { f32x4 s0, s1; unpack8(bj ? m1 : m0, s0, s1); v0 += s0; v1 += s1; }
                *(u32x4*)((MODE <= 1 ? MS : MB) + off + bj * HALF) = pack8(v0, v1); }
            asm volatile("" ::: "memory"); }
#undef EM_LOAD
    }
};
struct EpiRes {
    static constexpr bool PERM = true, AFTER_DRAIN = false;
    const float* base; float* outf; bf16_t* XB; float* ssp; unsigned char* XB8;
    __device__ __forceinline__ void operator()(const f32x4 (&acc)[2][2][4][2], const Unit& u, int wr, int wc, int fr, int fq) const {
        const int row0 = u.pm * BM + wr * 64 + fr, col0 = u.pn * BM + wc * 32 + 8 * fq;
        f32x4 bb[3][4];
#define ER_LOAD(g_) do { const float* bp_ = base + (size_t)(row0 + ((g_) >> 2) * HALF + ((g_) & 3) * 16) * 4096 + col0; \
            bb[(g_) % 3][0] = *(const f32x4*)bp_; bb[(g_) % 3][1] = *(const f32x4*)(bp_ + 4); bb[(g_) % 3][2] = *(const f32x4*)(bp_ + HALF); bb[(g_) % 3][3] = *(const f32x4*)(bp_ + HALF + 4); } while (0)
        ER_LOAD(0); ER_LOAD(1);
#pragma unroll
        for (int g = 0; g < 8; ++g) { const int ai = g >> 2, m = g & 3, row = row0 + ai * HALF + m * 16; const size_t off = (size_t)row * 4096 + col0; float q = 0.f;
            const f32x4 b00 = bb[g % 3][0], b01 = bb[g % 3][1], b10 = bb[g % 3][2], b11 = bb[g % 3][3];
            if (g + 2 < 8) ER_LOAD(g + 2);
#pragma unroll
            for (int bj = 0; bj < 2; ++bj) { const f32x4 v0 = acc[ai][bj][m][0] + (bj ? b10 : b00), v1 = acc[ai][bj][m][1] + (bj ? b11 : b01);
                float* op = outf + off + bj * HALF; *(f32x4*)op = v0; *(f32x4*)(op + 4) = v1;
                if (XB) *(u32x4*)(XB + off + bj * HALF) = pack8(v0, v1);
                if (XB8) { typedef unsigned u32x2_ __attribute__((ext_vector_type(2))); u32x2_ w8; { int w = 0; w = __builtin_amdgcn_cvt_pk_fp8_f32(v0[0], v0[1], w, false); w = __builtin_amdgcn_cvt_pk_fp8_f32(v0[2], v0[3], w, true); w8.x = (unsigned)w; }
                    { int w = 0; w = __builtin_amdgcn_cvt_pk_fp8_f32(v1[0], v1[1], w, false); w = __builtin_amdgcn_cvt_pk_fp8_f32(v1[2], v1[3], w, true); w8.y = (unsigned)w; } *(u32x2_*)(XB8 + off + bj * HALF) = w8; }
                q += (v0[0] * v0[0] + v0[1] * v0[1]) + (v0[2] * v0[2] + v0[3] * v0[3]) + (v1[0] * v1[0] + v1[1] * v1[1]) + (v1[2] * v1[2] + v1[3] * v1[3]); }
            if (ssp) { q += __shfl_xor(q, 16); q += __shfl_xor(q, 32); if (fq == 0) ssp[(size_t)row * 64 + u.pn * 4 + wc] = q; }
            asm volatile("" ::: "memory"); }
#undef ER_LOAD
    }
};
struct EpiFf1 {
    static constexpr bool PERM = true, AFTER_DRAIN = false;
    RowScale rs; bf16_t* H;
    __device__ __forceinline__ void operator()(const f32x4 (&acc)[2][2][4][2], const Unit& u, int wr, int wc, int fr, int fq) const {
        const int row0 = u.pm * BM + wr * 64 + fr, col0 = u.pn * BM + wc * 32 + 8 * fq;
#pragma unroll
        for (int ai = 0; ai < 2; ++ai)
#pragma unroll
            for (int m = 0; m < 4; ++m) { const int row = row0 + ai * HALF + m * 16; const float r = rs.get(u.pm, ai * HALF + wr * 64 + m * 16 + fr);
#pragma unroll
                for (int bj = 0; bj < 2; ++bj) { f32x4 v0 = acc[ai][bj][m][0] * r, v1 = acc[ai][bj][m][1] * r;
#pragma unroll
                    for (int j = 0; j < 4; ++j) { const float a = fmaxf(v0[j], 0.f), b = fmaxf(v1[j], 0.f); v0[j] = a * a; v1[j] = b * b; }
                    *(u32x4*)(H + (size_t)row * 16384 + col0 + bj * HALF) = pack8(v0, v1); }
                asm volatile("" ::: "memory"); }
    }
};
template <class Epi, class Sched, bool ALIGN_EPI = false, bool SP2 = false, bool FP8 = false>
__device__ __forceinline__ void gemm_phase(PG8_LAS unsigned char* lds, const Gemm g, const Sched& S, const Epi& E) {
    int tid_ = threadIdx.x; asm volatile("" : "+v"(tid_));
    const int tid = tid_, wid = __builtin_amdgcn_readfirstlane(tid >> 6), lane = tid & 63, wr = wid >> 2, wc = wid & 3, fr = lane & 15, fq = lane >> 4;
    const int K = g.K, nt = K / BK;
    unsigned voffA[2], voffB[2];
#pragma unroll
    for (int i = 0; i < 2; ++i) { int R, C; stage_rc(tid * 16 + i * 8192, R, C); const int Rb = Epi::PERM ? ((R & ~31) + perm32(R & 31)) : R;
        voffA[i] = (unsigned)(R * K + C) * 2u; voffB[i] = (unsigned)(Rb * K + C) * 2u; }
    const size_t kstep = (size_t)(BK * 2);
    const size_t hstep = (size_t)HALF * K * 2;
    const size_t tstep = 2 * hstep;
    const unsigned ldsw = (unsigned)wid * 1024u;
    int aoffk[2], boffk[2];
#pragma unroll
    for (int k = 0; k < 2; ++k) { const int cc = FP8 ? (fq * 16 + k * 8) : (k * 32 + fq * 8); aoffk[k] = lds_byte(wr * 64 + fr, cc); boffk[k] = lds_byte(wc * 32 + fr, cc); }
#define PG8_SA(b, h) (((b) * 2 + (h)) * HTB)
#define PG8_SB(b, h) ((4 + (b) * 2 + (h)) * HTB)
#define PG8_STAGE(bufoff, gbase, voff) do { _Pragma("unroll") for (int _i = 0; _i < 2; ++_i) \
        __builtin_amdgcn_global_load_lds((const unsigned*)((const char*)(gbase) + (voff)[_i]), (PG8_LAS unsigned*)(lds + (bufoff) + ldsw + _i * 8192), 16, 0, 0); } while (0)
#define PG8_LDA(dst, b, h) do { _Pragma("unroll") for (int m = 0; m < 4; ++m) { if constexpr (FP8) { dst##8[m].lo = *(const PG8_LAS v4i_*)(lds + PG8_SA(b, h) + aoffk[0] + m * 2048); dst##8[m].hi = *(const PG8_LAS v4i_*)(lds + PG8_SA(b, h) + aoffk[1] + m * 2048); } \
        else { _Pragma("unroll") for (int k = 0; k < 2; ++k) dst[m][k] = *(const PG8_LAS bf16x8*)(lds + PG8_SA(b, h) + aoffk[k] + m * 2048); } } } while (0)
#define PG8_LDB(dst, b, h) do { _Pragma("unroll") for (int n = 0; n < 2; ++n) { if constexpr (FP8) { dst##8[n].lo = *(const PG8_LAS v4i_*)(lds + PG8_SB(b, h) + boffk[0] + n * 2048); dst##8[n].hi = *(const PG8_LAS v4i_*)(lds + PG8_SB(b, h) + boffk[1] + n * 2048); } \
        else { _Pragma("unroll") for (int k = 0; k < 2; ++k) dst[n][k] = *(const PG8_LAS bf16x8*)(lds + PG8_SB(b, h) + boffk[k] + n * 2048); } } } while (0)
#define PG8_MMA(ai, bj, At, Bt) do { __builtin_amdgcn_s_setprio(1); _Pragma("unroll") for (int m = 0; m < 4; ++m) _Pragma("unroll") for (int n = 0; n < 2; ++n) { \
        if constexpr (FP8) asm volatile("v_mfma_scale_f32_16x16x128_f8f6f4 %0, %1, %2, %0, %3, %3 op_sel_hi:[0,0,0]" : "+v"(acc[ai][bj][m][n]) : "v"(Bt##8[n]), "v"(At##8[m]), "v"(scl8)); \
        else { _Pragma("unroll") for (int k = 0; k < 2; ++k) acc[ai][bj][m][n] = __builtin_amdgcn_mfma_f32_16x16x32_bf16(Bt[n][k], At[m][k], acc[ai][bj][m][n], 0, 0, 0); } } \
        __builtin_amdgcn_s_setprio(0); } while (0)
#define PG8_WAIT_V(n) asm volatile("s_waitcnt vmcnt(" #n ")" ::: "memory")
#define PG8_WAIT_L(n) asm volatile("s_waitcnt lgkmcnt(" #n ")" ::: "memory")
#define PG8_BAR __builtin_amdgcn_s_barrier()
#define PG8_SCHED __builtin_amdgcn_sched_barrier(0)
    Unit cur, nxt; int ui = 0;
    if (!S.next(0, cur)) return;
    f32x4 acc[2][2][4][2];
#pragma unroll
    for (int a = 0; a < 2; ++a)
#pragma unroll
        for (int b = 0; b < 2; ++b)
#pragma unroll
            for (int m = 0; m < 4; ++m)
#pragma unroll
                for (int n = 0; n < 2; ++n) acc[a][b][m][n] = (f32x4){0.f, 0.f, 0.f, 0.f};
    bf16x8 At[4][2], B0[2][2], B1[2][2];
    typedef int v8i_ __attribute__((ext_vector_type(8))); typedef int v4i_ __attribute__((ext_vector_type(4)));
    v8i_ At8[4], B08[2], B18[2]; unsigned scl8 = 0x7f7f7f7fu; asm volatile("" : "+v"(scl8));
    (void)At8; (void)B08; (void)B18; (void)scl8;
    const char* cA = (const char*)g.A + (size_t)cur.pm * tstep; const char* cB = (const char*)g.Bt + (size_t)cur.pn * tstep;
    S.a_ready(cur);
    if constexpr (SP2) {
        PG8_STAGE(PG8_SB(0, 0), cB, voffB); PG8_STAGE(PG8_SB(0, 1), cB + hstep, voffB); PG8_STAGE(PG8_SA(0, 0), cA, voffA); PG8_STAGE(PG8_SA(0, 1), cA + hstep, voffA);
        if (wr == 1) PG8_BAR;
        PG8_WAIT_V(2); PG8_BAR;
        PG8_STAGE(PG8_SB(1, 0), cB + kstep, voffB); PG8_STAGE(PG8_SA(1, 0), cA + kstep, voffA); PG8_STAGE(PG8_SB(1, 1), cB + hstep + kstep, voffB);
        PG8_WAIT_V(6); PG8_BAR;
    } else {
        PG8_STAGE(PG8_SB(0, 0), cB, voffB); PG8_STAGE(PG8_SA(0, 0), cA, voffA); PG8_STAGE(PG8_SB(0, 1), cB + hstep, voffB); PG8_STAGE(PG8_SA(0, 1), cA + hstep, voffA);
        if (wr == 1) PG8_BAR;
        PG8_WAIT_V(4); PG8_BAR;
        PG8_STAGE(PG8_SB(1, 0), cB + kstep, voffB); PG8_STAGE(PG8_SA(1, 0), cA + kstep, voffA); PG8_STAGE(PG8_SB(1, 1), cB + hstep + kstep, voffB);
        PG8_WAIT_V(6); PG8_BAR;
    }
    for (;;) {
        const bool has_next = S.next(ui + 1, nxt);
        const char* nA = has_next ? (const char*)g.A + (size_t)nxt.pm * tstep : cA; const char* nB = has_next ? (const char*)g.Bt + (size_t)nxt.pn * tstep : cB;
        for (int t = 0; t < nt; t += 2) {
            const bool last = (t == nt - 2);
            const char* a1 = cA + (size_t)(t + 1) * kstep;
            const char* a2 = last ? nA : cA + (size_t)(t + 2) * kstep; const char* b2 = last ? nB : cB + (size_t)(t + 2) * kstep;
            const char* a3 = a2 + kstep; const char* b3 = b2 + kstep;
            if (last && has_next) S.a_ready(nxt);
            if constexpr (SP2) {
            PG8_LDB(B0, 0, 0); PG8_LDB(B1, 0, 1); PG8_SCHED; PG8_LDA(At, 0, 0); PG8_STAGE(PG8_SA(1, 1), a1 + hstep, voffA);
            PG8_WAIT_V(8); PG8_WAIT_L(0); PG8_BAR; PG8_MMA(0, 0, At, B0); PG8_MMA(0, 1, At, B1); PG8_BAR; PG8_SCHED;
            PG8_LDA(At, 0, 1); PG8_STAGE(PG8_SB(0, 0), b2, voffB); PG8_STAGE(PG8_SB(0, 1), b2 + hstep, voffB); PG8_STAGE(PG8_SA(0, 0), a2, voffA);
            PG8_WAIT_V(8); PG8_WAIT_L(0); PG8_BAR; PG8_MMA(1, 0, At, B0); PG8_MMA(1, 1, At, B1); PG8_BAR; PG8_SCHED;
            PG8_LDB(B0, 1, 0); PG8_LDB(B1, 1, 1); PG8_SCHED; PG8_LDA(At, 1, 0); PG8_STAGE(PG8_SA(0, 1), a2 + hstep, voffA);
            PG8_WAIT_V(8); PG8_WAIT_L(0); PG8_BAR; PG8_MMA(0, 0, At, B0); PG8_MMA(0, 1, At, B1); PG8_BAR; PG8_SCHED;
            PG8_LDA(At, 1, 1); PG8_STAGE(PG8_SB(1, 0), b3, voffB); PG8_STAGE(PG8_SB(1, 1), b3 + hstep, voffB); PG8_STAGE(PG8_SA(1, 0), a3, voffA);
            PG8_WAIT_V(8); PG8_WAIT_L(0); PG8_BAR; PG8_MMA(1, 0, At, B0); PG8_MMA(1, 1, At, B1); PG8_BAR; PG8_SCHED;
            } else {
            PG8_LDB(B0, 0, 0); PG8_SCHED; PG8_LDA(At, 0, 0); PG8_STAGE(PG8_SA(1, 1), a1 + hstep, voffA);
            PG8_WAIT_L(8); PG8_BAR; PG8_WAIT_L(0); PG8_MMA(0, 0, At, B0); PG8_BAR; PG8_SCHED;
            PG8_LDB(B1, 0, 1); PG8_STAGE(PG8_SB(0, 0), b2, voffB);
            PG8_BAR; PG8_WAIT_L(0); PG8_MMA(0, 1, At, B1); PG8_BAR;
            PG8_LDA(At, 0, 1); PG8_STAGE(PG8_SA(0, 0), a2, voffA);
            PG8_BAR; PG8_WAIT_L(0); PG8_MMA(1, 0, At, B0); PG8_BAR; PG8_SCHED;
            PG8_STAGE(PG8_SB(0, 1), b2 + hstep, voffB);
            PG8_WAIT_V(6); PG8_BAR; PG8_MMA(1, 1, At, B1); PG8_BAR;
            PG8_LDB(B0, 1, 0); PG8_SCHED; PG8_LDA(At, 1, 0); PG8_STAGE(PG8_SA(0, 1), a2 + hstep, voffA);
            PG8_WAIT_L(8); PG8_BAR; PG8_WAIT_L(0); PG8_MMA(0, 0, At, B0); PG8_BAR; PG8_SCHED;
            PG8_LDB(B1, 1, 1); PG8_STAGE(PG8_SB(1, 0), b3, voffB);
            PG8_BAR; PG8_WAIT_L(0); PG8_MMA(0, 1, At, B1); PG8_BAR;
            PG8_LDA(At, 1, 1); PG8_STAGE(PG8_SA(1, 0), a3, voffA);
            PG8_BAR; PG8_WAIT_L(0); PG8_MMA(1, 0, At, B0); PG8_BAR; PG8_SCHED;
            PG8_STAGE(PG8_SB(1, 1), b3 + hstep, voffB);
            PG8_WAIT_V(6); PG8_BAR; PG8_MMA(1, 1, At, B1); PG8_BAR;
            }
        }
        if constexpr (ALIGN_EPI) { if (wr == 0) PG8_BAR; }
        if constexpr (FP8) asm volatile("s_nop 15\n\ts_nop 15\n\ts_nop 15\n\ts_nop 15" ::: "memory");
        if constexpr (!Epi::AFTER_DRAIN) { E(acc, cur, wr, wc, fr, fq); S.done(cur); }
        if (!has_next) break;
#pragma unroll
        for (int a = 0; a < 2; ++a)
#pragma unroll
            for (int b = 0; b < 2; ++b)
#pragma unroll
                for (int m = 0; m < 4; ++m)
#pragma unroll
                    for (int n = 0; n < 2; ++n) acc[a][b][m][n] = (f32x4){0.f, 0.f, 0.f, 0.f};
        cur = nxt; cA = nA; cB = nB; ++ui;
        if constexpr (ALIGN_EPI) { if (wr == 1) PG8_BAR; }
    }
    PG8_WAIT_V(0);
    if constexpr (!ALIGN_EPI) { if (wr == 0) PG8_BAR; }
    PG8_BAR;
    if constexpr (Epi::AFTER_DRAIN) { E.fused(acc, cur, wr, wc, fr, fq, lds, wid, lane); S.done(cur); }
#undef PG8_SA
#undef PG8_SB
#undef PG8_STAGE
#undef PG8_LDA
#undef PG8_LDB
#undef PG8_MMA
#undef PG8_WAIT_V
#undef PG8_WAIT_L
#undef PG8_BAR
#undef PG8_SCHED
}
}
#define GAS __attribute__((address_space(1)))
#define LAS __attribute__((address_space(3)))
typedef unsigned short bf16;
typedef unsigned v4u __attribute__((ext_vector_type(4)));
typedef float f32x4 __attribute__((ext_vector_type(4)));
typedef short bf16x8 __attribute__((ext_vector_type(8)));
typedef GAS unsigned gu32;
typedef GAS unsigned long long gu64;
#define RLX_AGENT __ATOMIC_RELAXED, __HIP_MEMORY_SCOPE_AGENT
#define LDS_WAIT() asm volatile("s_waitcnt lgkmcnt(0)" ::: "memory")
#define VM_WAIT() asm volatile("s_waitcnt vmcnt(0)" ::: "memory")
__device__ __forceinline__ unsigned long long rt() { return __builtin_amdgcn_s_memrealtime(); }
__device__ __forceinline__ unsigned f2bf(float f) { unsigned u = __builtin_bit_cast(unsigned, f); return (u + 0x7fffu + ((u >> 16) & 1u)) >> 16; }
__device__ __forceinline__ unsigned pk2(float lo, float hi) { return f2bf(lo) | (f2bf(hi) << 16); }

#define XB_TMO      128
#define XB_XCNT(j)  (256  + 64 * (j))
#define XB_XSUB(j)  (1280 + 64 * (j))
#define XB_XGEN(j)  (2304 + 64 * (j))
#define XB_TOP      3328
#define XB_TOPGEN   3392
#define XCD_BAR_WORDS 3456
#define XB_SPIN_CAP (1u << 18)

__device__ __forceinline__ unsigned xb_ld(unsigned* p)              { return __hip_atomic_load(p, __ATOMIC_RELAXED, __HIP_MEMORY_SCOPE_AGENT); }
__device__ __forceinline__ unsigned xb_add(unsigned* p, unsigned v) { return __hip_atomic_fetch_add(p, v, __ATOMIC_RELAXED, __HIP_MEMORY_SCOPE_AGENT); }
__device__ __forceinline__ unsigned xb_xcc_id() { return (unsigned)__builtin_amdgcn_s_getreg((3 << 11) | 20) & 0xFu; }
#define XB_SPIN(cond, bar) do { unsigned _sp = 0; while (cond) { __builtin_amdgcn_s_sleep(1); \
    if ((++_sp & 255u) == 0u) { if (xb_ld(&(bar)[XB_TMO])) break; if (_sp > XB_SPIN_CAP) { atomicAdd(&(bar)[XB_TMO], 1u); break; } } } } while (0)

struct XcdBarrier {
    unsigned* bar; unsigned x;
    volatile LAS unsigned* st;
};

__device__ __forceinline__ XcdBarrier xcd_barrier_post(unsigned* bar, volatile LAS unsigned* st) {
    XcdBarrier b; b.bar = bar; b.x = xb_xcc_id(); b.st = st;
    if (threadIdx.x == 0) (void)xb_add(&bar[XB_XCNT(b.x)], 1u);
    return b;
}
__device__ __forceinline__ void xcd_barrier_complete(unsigned* bar, unsigned x, unsigned& nloc, unsigned& nx) {
    const unsigned G = gridDim.x * gridDim.y * gridDim.z;
    unsigned sum, cnt, mine, sp = 0u;
    for (;;) {
        sum = 0u; cnt = 0u; mine = 0u;
#pragma unroll
        for (unsigned j = 0; j < 16; ++j) { const unsigned c = xb_ld(&bar[XB_XCNT(j)]); sum += c; cnt += (c > 0u) ? 1u : 0u; mine = (j == x) ? c : mine; }
        if (sum == G) break;
        __builtin_amdgcn_s_sleep(1);
        if ((++sp & 255u) == 0u) { if (xb_ld(&bar[XB_TMO])) break; if (sp > XB_SPIN_CAP) { atomicAdd(&bar[XB_TMO], 1u); break; } }
    }
    nloc = mine > 0u ? mine : 1u; nx = cnt > 0u ? cnt : 1u;
}

__device__ __forceinline__ void xcd_barrier(const XcdBarrier& b) {
    asm volatile("s_waitcnt vmcnt(0)" ::: "memory");
    __syncthreads();
    if (threadIdx.x == 0) {
        unsigned* bar = b.bar;
        __builtin_amdgcn_s_waitcnt(0);
        unsigned nloc = b.st[0], nx = b.st[1];
        if (nloc == 0u) { xcd_barrier_complete(bar, b.x, nloc, nx); b.st[0] = nloc; b.st[1] = nx; }
        const unsigned old = xb_add(&bar[XB_XSUB(b.x)], 1u);
        const unsigned gen = old / nloc;
        if (old + 1u == (gen + 1u) * nloc) {
            __builtin_amdgcn_fence(__ATOMIC_RELEASE, "agent");
            asm volatile("s_waitcnt vmcnt(0)" ::: "memory");
            const unsigned og = xb_add(&bar[XB_TOP], 1u);
            const unsigned tg = og / nx;
            if (og + 1u == (tg + 1u) * nx) xb_add(&bar[XB_TOPGEN], 1u);
            else XB_SPIN(xb_ld(&bar[XB_TOPGEN]) == tg, bar);
            __builtin_amdgcn_fence(__ATOMIC_ACQUIRE, "agent");
            xb_add(&bar[XB_XGEN(b.x)], 1u);
            asm volatile("s_waitcnt vmcnt(0)" ::: "memory");
        } else {
            XB_SPIN(xb_ld(&bar[XB_XGEN(b.x)]) == gen, bar);
            __builtin_amdgcn_fence(__ATOMIC_ACQUIRE, "agent");
            asm volatile("s_waitcnt vmcnt(0)" ::: "memory");
        }
    }
    __syncthreads();
}

constexpr int NWAVES = 8;
constexpr int NB = 2, SEQ = 4096, DM = 4096, M = NB * SEQ, NL = 2, INW = 22528, DFF = 16384;
constexpr int SSMW = 1024, NGRP = 64, NST = 64, CAW = 1536, DAW = 1536, QKVW = 9216, GTW = 12288;
constexpr int CA_H = 12, DA_H = 6, HD = 128;
constexpr float EPS = 1e-6f, LOG2E = 1.4426950408889634f, QSCALE = 0.08838834764831845f * 1.4426950408889634f;
#ifndef MK_N_LAUNCHES
#define MK_N_LAUNCHES 1
#endif
constexpr int N_PHASES = 1 + 8 * NL;
constexpr int N_LAUNCHES = MK_N_LAUNCHES;
static_assert(N_LAUNCHES == 1 || N_LAUNCHES == N_PHASES, "MK_N_LAUNCHES is 1 or 17");

constexpr size_t MiB = 1u << 20;
constexpr size_t WS_CTL = 0, CTL_ZERO_BYTES = 1 * MiB;
constexpr size_t WS_TAB = 1 * MiB, WS_SE = 5 * MiB;
constexpr size_t WS_WT = 16 * MiB, WT_IN = 0, WT_GLU = 176 * MiB, WT_OA = 178 * MiB, WT_OB = 186 * MiB, WT_OC = 198 * MiB, WT_O = 210 * MiB, WT_F1 = 242 * MiB, WT_F2 = 370 * MiB, WT_LAYER = 498 * MiB;
constexpr size_t WS_XB = WS_WT + NL * WT_LAYER;
constexpr size_t WS_UA = WS_XB + 64 * MiB, WS_QKV = WS_UA + 32 * MiB, WS_GT = WS_QKV + 144 * MiB, WS_H = WS_QKV  ;
constexpr size_t WS_Z = WS_GT + 192 * MiB, WS_YA = WS_Z + 16 * MiB, WS_YB = WS_YA + 16 * MiB, WS_YC = WS_YB + 24 * MiB, WS_MF = WS_YC + 24 * MiB, WS_MB = WS_MF + 128 * MiB;
constexpr size_t WS_X1 = WS_MB + 64 * MiB, WS_SSP = WS_X1 + 128 * MiB  , WS_XB8 = WS_SSP + 8 * MiB  , WS_END = WS_XB8 + 32 * MiB;
constexpr size_t WT_G8 = 80 * MiB;
constexpr int NQ = 10240, NGATE = 12288;
constexpr float GATE_WSCALE = 64.0f;
static_assert((size_t)INW * DM * 2 == 176 * MiB && (size_t)M * QKVW * 2 == 144 * MiB && (size_t)M * GTW * 2 == 192 * MiB && (size_t)M * DFF * 2 <= 336 * MiB, "ws map");
constexpr int TAB_A = 0, TAB_AL = 16384, TAB_LAM = 32768, TAB_G = 33024  , TAB_B = 65536;
constexpr int CW_TMO = 0, CW_CODE = 1, CW_BAR = 4096, CW_Q = 8192  , CW_SS = 16384  ;
static_assert((CW_SS + 4 * M) * 4 <= (int)CTL_ZERO_BYTES, "ctl");

constexpr int RING_OFF = 0, RING_BYTES = 131072;
constexpr int LDSCTL_OFF = RING_BYTES, MISC_OFF = LDSCTL_OFF + 320;
constexpr int EPI_TAB_OFF = 135168;
constexpr int LDS_BYTES = 147456;

static_assert(EPI_O_UA == WS_UA && EPI_O_QKV == WS_QKV && EPI_O_GT == WS_GT && EPI_O_GTAB == WS_TAB + (size_t)TAB_G * 4, "epilogue offsets vs ws map");

typedef unsigned v2u __attribute__((ext_vector_type(2)));
typedef float f32x2 __attribute__((ext_vector_type(2)));
__device__ __forceinline__ int fresh_tid() { int t = threadIdx.x; asm volatile("" : "+v"(t)); return t; }
struct Frame {
    LAS unsigned char* lds;
    volatile LAS unsigned* MISC;
    gu32* ctl;
    int wave, G;
    const float* const* in;
    unsigned char* ws;
};
__device__ __forceinline__ float wave_sum(float v) {
#pragma unroll
    for (int o = 1; o < 64; o <<= 1) v += __shfl_xor(v, o);
    return v;
}
__device__ __forceinline__ float wave_max(float v) {
#pragma unroll
    for (int o = 1; o < 64; o <<= 1) v = fmaxf(v, __shfl_xor(v, o));
    return v;
}
typedef float f32x2_cv __attribute__((ext_vector_type(2))); typedef __bf16 bf16x2_cv __attribute__((ext_vector_type(2)));
__device__ __forceinline__ unsigned cvtpk(float lo, float hi) { const f32x2_cv v = {lo, hi}; const bf16x2_cv b = __builtin_convertvector(v, bf16x2_cv); return __builtin_bit_cast(unsigned, b); }
__device__ __forceinline__ float bflo(unsigned w) { return __uint_as_float(w << 16); }
__device__ __forceinline__ float bfhi(unsigned w) { return __uint_as_float(w & 0xffff0000u); }

__device__ __forceinline__ double d_exp(double x) {
    const double k = __builtin_rint(x * 1.4426950408889634); const double r = __builtin_fma(-k, 0.6931471805599453, x) - k * 2.3190468138462996e-17;
    double s = 1.0;
#pragma unroll
    for (int i = 16; i >= 1; --i) s = 1.0 + s * r * (1.0 / (double)i);
    return s * __longlong_as_double((long long)(1023 + (int)k) << 52);
}
__device__ __forceinline__ void d_sincos(double x, double& s, double& c) {
    const double n = __builtin_rint(x * 0.6366197723675814);
    double r = __builtin_fma(-n, 1.5707963267948966, x); r = __builtin_fma(-n, 6.123233995736766e-17, r);
    const double r2 = r * r;
    double sp = -1.0 / 1307674368000.0; sp = sp * r2 + 1.0 / 6227020800.0; sp = sp * r2 - 1.0 / 39916800.0; sp = sp * r2 + 1.0 / 362880.0; sp = sp * r2 - 1.0 / 5040.0; sp = sp * r2 + 1.0 / 120.0; sp = sp * r2 - 1.0 / 6.0; sp = sp * r2 + 1.0; sp *= r;
    double cp = 1.0 / 20922789888000.0; cp = cp * r2 - 1.0 / 87178291200.0; cp = cp * r2 + 1.0 / 479001600.0; cp = cp * r2 - 1.0 / 3628800.0; cp = cp * r2 + 1.0 / 40320.0; cp = cp * r2 - 1.0 / 720.0; cp = cp * r2 + 1.0 / 24.0; cp = cp * r2 - 0.5; cp = cp * r2 + 1.0;
    const int q = ((int)n) & 3;
    s = (q == 0) ? sp : (q == 1) ? cp : (q == 2) ? -sp : -cp;
    c = (q == 0) ? cp : (q == 1) ? -sp : (q == 2) ? -cp : sp;
}

#define TR_LOAD(it_) do { const int g_ = (it_) >> 3, kq_ = g_ / nblk, nb_ = g_ - kq_ * nblk, kb_ = kq_ * 8 + ((it_) & 7); \
        _Pragma("unroll") for (int i = 0; i < 16; ++i) { const int k = kb_ * 64 + 8 * (i >> 1) + 2 * r + (i & 1); v[i] = __builtin_nontemporal_load((const GAS f32x4*)(W + (size_t)k * ldw + nb_ * 64 + 4 * c4)); } \
        if (gain) { _Pragma("unroll") for (int i = 0; i < 16; ++i) gv[i] = gain[kb_ * 64 + 8 * (i >> 1) + 2 * r + (i & 1)]; } } while (0)
__device__ __forceinline__ void tr_range(const Frame& F, const float* W, int K, int N, int ldw, const float* gain, bf16* WT, int it0, int NGW, int nitems) {
    LAS unsigned* scr = (LAS unsigned*)(F.lds + RING_OFF + F.wave * 8192);
    const int gw = it0, nblk = N >> 6;
    const int lane = fresh_tid() & 63, r = lane >> 4, c4 = lane & 15;
    f32x4 v[16]; float gv[16];
    int it = gw;
    if (it < nitems) TR_LOAD(it);
    while (it < nitems) {
        const int g = it >> 3, kq = g / nblk, nb = g - kq * nblk, kb = kq * 8 + (it & 7), k0 = kb * 64, n0 = nb * 64;
        if (gain) {
#pragma unroll
            for (int i = 0; i < 16; ++i) v[i] = v[i] * gv[i];
        }
#pragma unroll
        for (int a = 0; a < 8; ++a)
#pragma unroll
            for (int j = 0; j < 4; ++j) scr[(4 * c4 + j) * 32 + 4 * (a ^ (c4 & 7)) + r] = cvtpk(v[2 * a][j], v[2 * a + 1][j]);
        const int nx = it + NGW;
        if (nx < nitems) TR_LOAD(nx);
        LDS_WAIT(); asm volatile("" ::: "memory");
#pragma unroll
        for (int jj = 0; jj < 8; ++jj) { const int idx = lane + 64 * jj, n = idx >> 3, c = idx & 7;
            const v4u o = *(const LAS v4u*)(scr + n * 32 + 4 * (c ^ ((n >> 2) & 7)));
            __builtin_nontemporal_store(o, (GAS v4u*)(WT + (size_t)(n0 + n) * K + k0 + 8 * c)); }
        LDS_WAIT(); asm volatile("" ::: "memory");
        it = nx;
    }
}
#undef TR_LOAD
__device__ __forceinline__ unsigned pack_fp8x4(float a, float b, float c, float d) { int w = 0; w = __builtin_amdgcn_cvt_pk_fp8_f32(a, b, w, false); w = __builtin_amdgcn_cvt_pk_fp8_f32(c, d, w, true); return (unsigned)w; }
#define TR_LOAD8(it_) do { const int g_ = (it_) >> 3, kq_ = g_ / nblk, nb_ = g_ - kq_ * nblk, kb_ = kq_ * 8 + ((it_) & 7); \
        _Pragma("unroll") for (int i = 0; i < 16; ++i) { const int k = kb_ * 64 + 16 * (i >> 2) + 4 * r + (i & 3); v[i] = __builtin_nontemporal_load((const GAS f32x4*)(W + (size_t)k * ldw + nb_ * 64 + 4 * c4)); } \
        _Pragma("unroll") for (int i = 0; i < 16; ++i) gv[i] = gain[kb_ * 64 + 16 * (i >> 2) + 4 * r + (i & 3)]; } while (0)
__device__ __forceinline__ void tr_range8(const Frame& F, const float* W, int K, int N, int ldw, const float* gain, float scale, unsigned char* WT, int it0, int NGW, int nitems) {
    LAS unsigned* scr = (LAS unsigned*)(F.lds + RING_OFF + F.wave * 8192);
    const int gw = it0, nblk = N >> 6;
    const int lane = fresh_tid() & 63, r = lane >> 4, c4 = lane & 15;
    f32x4 v[16]; float gv[16];
    int it = gw;
    if (it < nitems) TR_LOAD8(it);
    while (it < nitems) {
        const int g = it >> 3, kq = g / nblk, nb = g - kq * nblk, kb = kq * 8 + (it & 7), k0 = kb * 64, n0 = nb * 64;
#pragma unroll
        for (int i = 0; i < 16; ++i) v[i] = v[i] * (gv[i] * scale);
#pragma unroll
        for (int a = 0; a < 4; ++a)
#pragma unroll
            for (int j = 0; j < 4; ++j) scr[(4 * c4 + j) * 16 + 4 * (a ^ (c4 & 3)) + r] = pack_fp8x4(v[4 * a][j], v[4 * a + 1][j], v[4 * a + 2][j], v[4 * a + 3][j]);
        const int nx = it + NGW;
        if (nx < nitems) TR_LOAD8(nx);
        LDS_WAIT(); asm volatile("" ::: "memory");
#pragma unroll
        for (int jj = 0; jj < 4; ++jj) { const int idx = lane + 64 * jj, n = idx >> 2, c = idx & 3;
            const v4u o = *(const LAS v4u*)(scr + n * 16 + 4 * (c ^ ((n >> 2) & 3)));
            __builtin_nontemporal_store(o, (GAS v4u*)(WT + (size_t)(n0 + n) * K + k0 + 16 * c)); }
        LDS_WAIT(); asm volatile("" ::: "memory");
        it = nx;
    }
}
#undef TR_LOAD8

struct Args { const float* in[30]; float* out; unsigned char* ws; int ph_lo, ph_hi, li, pad; };
typedef const __attribute__((address_space(4))) Args* KArgs;
enum { I_X = 0, I_NORM_MIX, I_W_IN, I_A_RE, I_A_IM, I_LOG_DT, I_B_RE, I_B_IM, I_C_RE, I_C_IM, I_SSM_D, I_W_GLU, I_B_GLU, I_CA_QG, I_CA_KG, I_CA_BIAS, I_DA_QG, I_DA_KG,
       I_LQ1, I_LK1, I_LQ2, I_LK2, I_SUBLN, I_W_OA, I_W_OB, I_W_OC, I_W_O, I_NORM_MLP, I_W_FF1, I_W_FF2 };
__device__ __forceinline__ float lambda_init_of(int l) { return l == 0 ? 0.2f : 0.35550906759096926f; }

constexpr int CONV_REST = 644, CONV_WIN = 352;
__device__ __forceinline__ void conv_chunk(const Frame& F, KArgs A, int L, int c) {
    const float* W; int K, N, ldw, cc = c, Lw = L; const float* gain = nullptr; size_t wto; bool f8 = false;
    if (c < 4)        { W = A->in[I_W_GLU] + (size_t)L * SSMW * SSMW; K = SSMW; N = SSMW; ldw = SSMW; wto = WT_GLU; }
    else if (c < 20)  { cc = c - 4;   W = A->in[I_W_OA] + (size_t)L * SSMW * DM; K = SSMW; N = DM; ldw = DM; wto = WT_OA; }
    else if (c < 44)  { cc = c - 20;  W = A->in[I_W_OB] + (size_t)L * CAW * DM; K = CAW; N = DM; ldw = DM; wto = WT_OB; }
    else if (c < 68)  { cc = c - 44;  W = A->in[I_W_OC] + (size_t)L * DAW * DM; K = DAW; N = DM; ldw = DM; wto = WT_OC; }
    else if (c < 132) { cc = c - 68;  W = A->in[I_W_O] + (size_t)L * DM * DM; K = DM; N = DM; ldw = DM; wto = WT_O; }
    else if (c < 388) { cc = c - 132; W = A->in[I_W_FF1] + (size_t)L * DM * DFF; K = DM; N = DFF; ldw = DFF; gain = A->in[I_NORM_MLP] + L * DM; wto = WT_F1; }
    else if (c < 644) { cc = c - 388; W = A->in[I_W_FF2] + (size_t)L * DFF * DM; K = DFF; N = DM; ldw = DM; wto = WT_F2; }
    else if (c < 804) { cc = c - 644; Lw = L + 1; W = A->in[I_W_IN] + (size_t)Lw * DM * INW; K = DM; N = NQ; ldw = INW; gain = A->in[I_NORM_MIX] + Lw * DM; wto = WT_IN; }
    else              { cc = c - 804; Lw = L + 1; W = A->in[I_W_IN] + (size_t)Lw * DM * INW + NQ; K = DM; N = NGATE; ldw = INW; gain = A->in[I_NORM_MIX] + Lw * DM; wto = WT_IN + WT_G8; f8 = true; }
    unsigned char* wt = A->ws + WS_WT + (size_t)Lw * WT_LAYER + wto;
    if (f8) tr_range8(F, W, K, N, ldw, gain, GATE_WSCALE, wt, cc * 64 + F.wave, 8, cc * 64 + 64);
    else tr_range(F, W, K, N, ldw, gain, (bf16*)wt, cc * 64 + F.wave, 8, cc * 64 + 64);
}

__device__ __forceinline__ void p0_prologue(const Frame& F, KArgs A) {
    unsigned char* ws = A->ws;
    {
        unsigned char* wl = ws + WS_WT;
        const int gw = blockIdx.x * NWAVES + F.wave, NGW = F.G * NWAVES;
        tr_range(F, A->in[I_W_IN], DM, NQ, INW, A->in[I_NORM_MIX], (bf16*)(wl + WT_IN), gw, NGW, (DM >> 6) * (NQ >> 6));
        tr_range8(F, A->in[I_W_IN] + NQ, DM, NGATE, INW, A->in[I_NORM_MIX], GATE_WSCALE, wl + WT_IN + WT_G8, gw, NGW, (DM >> 6) * (NGATE >> 6));
    }
    {
        const int gw = blockIdx.x * NWAVES + F.wave, NGW = F.G * NWAVES;
        float* ssp = (float*)(ws + WS_SSP);
        for (int m = gw; m < M; m += NGW) {
            const GAS f32x4* xr = (const GAS f32x4*)(A->in[I_X] + (size_t)m * DM) + (fresh_tid() & 63); GAS v2u* o = (GAS v2u*)((bf16*)(ws + WS_XB) + (size_t)m * DM) + (fresh_tid() & 63); float s = 0.f;
            GAS unsigned* o8 = (GAS unsigned*)(ws + WS_XB8 + (size_t)m * DM) + (fresh_tid() & 63);
            f32x4 v[16];
#pragma unroll
            for (int j = 0; j < 16; ++j) v[j] = xr[64 * j];
#pragma unroll
            for (int j = 0; j < 16; ++j) { s += (v[j].x * v[j].x + v[j].y * v[j].y) + (v[j].z * v[j].z + v[j].w * v[j].w); v2u w; w.x = cvtpk(v[j].x, v[j].y); w.y = cvtpk(v[j].z, v[j].w); o[64 * j] = w; o8[64 * j] = pack_fp8x4(v[j].x, v[j].y, v[j].z, v[j].w); }
            s = wave_sum(s); ssp[(size_t)m * 64 + (fresh_tid() & 63)] = ((fresh_tid() & 63) == 0) ? s : 0.f;
        }
    }
    {
        float* tab = (float*)(ws + WS_TAB);
        const int gt = blockIdx.x * (NWAVES * 64) + fresh_tid();
        if (gt < NL * NGRP * NST) {
            const int l = gt / (NGRP * NST), g = (gt / NST) % NGRP, p = gt % NST;
            const double lr = (double)fminf(A->in[I_A_RE][gt], -1e-4f), li = (double)A->in[I_A_IM][gt];
            const double dt = d_exp((double)A->in[I_LOG_DT][l * NGRP + g]);
            double e = d_exp(lr * dt), sn, cs; d_sincos(li * dt, sn, cs);
            const double ar = e * cs, ai = e * sn;
            tab[TAB_A + 2 * gt] = (float)ar; tab[TAB_A + 2 * gt + 1] = (float)ai;
            e = d_exp(lr * dt * 64.0); d_sincos(li * dt * 64.0, sn, cs);
            tab[TAB_AL + 2 * gt] = (float)(e * cs); tab[TAB_AL + 2 * gt + 1] = (float)(e * sn);
            const double nr = ar - 1.0, ni = ai, den = lr * lr + li * li, fr = (nr * lr + ni * li) / den, fi = (ni * lr - nr * li) / den;
#pragma unroll 4
            for (int h = 0; h < 16; ++h) { const double br = (double)A->in[I_B_RE][(size_t)gt * 16 + h], bi = (double)A->in[I_B_IM][(size_t)gt * 16 + h];
                tab[TAB_B + ((size_t)gt * 16 + h) * 2] = (float)(fr * br - fi * bi); tab[TAB_B + ((size_t)gt * 16 + h) * 2 + 1] = (float)(fr * bi + fi * br); }
        }
        if (gt < NL * 4 * HD) { const int ll = gt / (4 * HD), k = (gt / HD) & 3, d = gt % HD;
            tab[TAB_G + gt] = A->in[k == 0 ? I_CA_QG : k == 1 ? I_CA_KG : k == 2 ? I_DA_QG : I_DA_KG][ll * HD + d] * ((k & 1) ? 1.0f : QSCALE); }
        if (gt < NL) {
            double s1 = 0.0, s2 = 0.0;
            for (int i = 0; i < HD; ++i) { s1 += (double)A->in[I_LQ1][gt * HD + i] * (double)A->in[I_LK1][gt * HD + i]; s2 += (double)A->in[I_LQ2][gt * HD + i] * (double)A->in[I_LK2][gt * HD + i]; }
            tab[TAB_LAM + gt] = (float)(d_exp(s1) - d_exp(s2) + (double)lambda_init_of(gt));
        }
    }
}

__device__ __forceinline__ float gelu_tanh(float y) { const float t = 0.7978845608028654f * (y + 0.044715f * y * y * y); const float e = __expf(2.0f * t); return 0.5f * y * (2.0f - 2.0f / (e + 1.0f)); }

__device__ __forceinline__ int q_pop(const Frame& F, gu32* head) {
    __syncthreads();
    if (fresh_tid() == 0) F.MISC[0] = __hip_atomic_fetch_add(head, 1u, RLX_AGENT);
    __syncthreads();
    return (int)F.MISC[0];
}

constexpr int SSM_UNITS = NB * NGRP * 8;
typedef float f32x16s __attribute__((ext_vector_type(16)));
__device__ __forceinline__ void split8(const f32x4 a, const f32x4 b, bf16x8& hi, bf16x8& lo) {
    v4u h, l2; h.x = cvtpk(a[0], a[1]); h.y = cvtpk(a[2], a[3]); h.z = cvtpk(b[0], b[1]); h.w = cvtpk(b[2], b[3]);
    l2.x = cvtpk(a[0] - bflo(h.x), a[1] - bfhi(h.x)); l2.y = cvtpk(a[2] - bflo(h.y), a[3] - bfhi(h.y)); l2.z = cvtpk(b[0] - bflo(h.z), b[1] - bfhi(h.z)); l2.w = cvtpk(b[2] - bflo(h.w), b[3] - bfhi(h.w));
    hi = *reinterpret_cast<bf16x8*>(&h); lo = *reinterpret_cast<bf16x8*>(&l2);
}
struct SsmB { bf16x8 h[4], l[4]; float ar0, ai0, ar1, ai1; };
__device__ __forceinline__ void ssm_load_b(SsmB& Bf, const float* tab, int l, int g, int lane) {
    const int c = lane & 31, hk = lane >> 5;
#pragma unroll
    for (int st = 0; st < 2; ++st) { const int gi = (l * NGRP + g) * NST + st * 32 + c; const float* bp = tab + TAB_B + ((size_t)gi * 16 + 8 * hk) * 2;
        const f32x4 v0 = *(const GAS f32x4*)bp, v1 = *(const GAS f32x4*)(bp + 4), v2 = *(const GAS f32x4*)(bp + 8), v3 = *(const GAS f32x4*)(bp + 12);
        split8((f32x4){v0[0], v0[2], v1[0], v1[2]}, (f32x4){v2[0], v2[2], v3[0], v3[2]}, Bf.h[2 * st], Bf.l[2 * st]);
        split8((f32x4){v0[1], v0[3], v1[1], v1[3]}, (f32x4){v2[1], v2[3], v3[1], v3[3]}, Bf.h[2 * st + 1], Bf.l[2 * st + 1]);
        const float ar = tab[TAB_A + 2 * gi], ai = tab[TAB_A + 2 * gi + 1]; if (st == 0) { Bf.ar0 = ar; Bf.ai0 = ai; } else { Bf.ar1 = ar; Bf.ai1 = ai; } }
}
struct SsmU { f32x4 a, b; };
__device__ __forceinline__ SsmU ssm_ld_u(const float* UA, size_t tok0, int g, int lane) {
    const int R = lane & 31, hk = lane >> 5, tau = 16 * ((R >> 2) & 1) + (R & 3) + 4 * (R >> 3);
    const float* up = UA + (tok0 + tau) * SSMW + g * 16 + 8 * hk;
    SsmU u; u.a = *(const GAS f32x4*)up; u.b = *(const GAS f32x4*)(up + 4); return u;
}
__device__ __forceinline__ void ssm_bu32(f32x16s (&acc)[4], const SsmB& Bf, const SsmU& u) {
    bf16x8 uh, ul; split8(u.a, u.b, uh, ul);
#pragma unroll
    for (int cb = 0; cb < 4; ++cb) { f32x16s a = {};
        a = __builtin_amdgcn_mfma_f32_32x32x16_bf16(ul, Bf.h[cb], a, 0, 0, 0); a = __builtin_amdgcn_mfma_f32_32x32x16_bf16(uh, Bf.l[cb], a, 0, 0, 0); a = __builtin_amdgcn_mfma_f32_32x32x16_bf16(uh, Bf.h[cb], a, 0, 0, 0);
        acc[cb] = a; }
    asm volatile("" :: "v"(uh), "v"(ul));
}
__device__ __forceinline__ void ssm_stage_a(const Frame& F, KArgs A, int l) {
    int lane_ = fresh_tid(); const int lane = lane_ & 63, c32 = lane & 31;
    const float* tab = (const float*)(A->ws + WS_TAB); const float* UA = (const float*)(A->ws + WS_UA); float* SE = (float*)(A->ws + WS_SE);
    for (int un = blockIdx.x; un < SSM_UNITS; un += F.G) {
        const int span = un & 7, bg = un >> 3, b = bg / NGRP, g = bg % NGRP, c = span * 8 + F.wave;
        SsmB Bf; ssm_load_b(Bf, tab, l, g, lane);
        float x0r = 0.f, x0i = 0.f, x1r = 0.f, x1i = 0.f;
        const SsmU u0 = ssm_ld_u(UA, (size_t)b * SEQ + c * 64, g, lane), u1 = ssm_ld_u(UA, (size_t)b * SEQ + c * 64 + 32, g, lane);
#pragma unroll 1
        for (int rb = 0; rb < 2; ++rb) {
            f32x16s acc[4]; ssm_bu32(acc, Bf, rb ? u1 : u0);
#pragma unroll
            for (int ph = 0; ph < 2; ++ph) {
                if (ph == 1) { x0r = __shfl(x0r, c32); x0i = __shfl(x0i, c32); x1r = __shfl(x1r, c32); x1i = __shfl(x1i, c32); }
#pragma unroll
                for (int r = 0; r < 16; ++r) { const float n0r = Bf.ar0 * x0r - Bf.ai0 * x0i + acc[0][r], n0i = Bf.ar0 * x0i + Bf.ai0 * x0r + acc[1][r]; x0r = n0r; x0i = n0i;
                    const float n1r = Bf.ar1 * x1r - Bf.ai1 * x1i + acc[2][r], n1i = Bf.ar1 * x1i + Bf.ai1 * x1r + acc[3][r]; x1r = n1r; x1i = n1i; }
            }
            x0r = __shfl(x0r, 32 + c32); x0i = __shfl(x0i, 32 + c32); x1r = __shfl(x1r, 32 + c32); x1i = __shfl(x1i, 32 + c32);
        }
        if (lane < 32) { float* ep = SE + ((size_t)(bg * 64 + c) * NST) * 2; *(GAS f32x2*)(ep + 2 * c32) = (f32x2){x0r, x0i}; *(GAS f32x2*)(ep + 2 * (32 + c32)) = (f32x2){x1r, x1i}; }
    }
}
__device__ __forceinline__ void ssm_stage_c(const Frame& F, KArgs A, int l, int un) {
    int lane_ = fresh_tid(); const int lane = lane_ & 63, c32 = lane & 31, hi = lane >> 5, t16 = lane & 15, kk = lane >> 4;
    const float* tab = (const float*)(A->ws + WS_TAB); const float* UA = (const float*)(A->ws + WS_UA); const float* SE = (const float*)(A->ws + WS_SE); bf16* Z = (bf16*)(A->ws + WS_Z);
    LAS unsigned char* xs = F.lds + RING_OFF + F.wave * 9216;
    const int span = un & 7, bg = un >> 3, b = bg / NGRP, g = bg % NGRP, c = span * 8 + F.wave;
    bf16x8 Ch[4], Cl[4];
    { const float* cre = A->in[I_C_RE] + (size_t)(l * NGRP + g) * 16 * NST + t16 * NST; const float* cim = A->in[I_C_IM] + (size_t)(l * NGRP + g) * 16 * NST + t16 * NST;
#pragma unroll
      for (int s4 = 0; s4 < 4; ++s4) { const f32x4 re = *(const f32x4*)(cre + 16 * s4 + 4 * kk), im = *(const f32x4*)(cim + 16 * s4 + 4 * kk);
          split8((f32x4){re[0], -im[0], re[1], -im[1]}, (f32x4){re[2], -im[2], re[3], -im[3]}, Ch[s4], Cl[s4]); } }
    SsmB Bf; ssm_load_b(Bf, tab, l, g, lane);
    const SsmU u0 = ssm_ld_u(UA, (size_t)b * SEQ + c * 64, g, lane), u1 = ssm_ld_u(UA, (size_t)b * SEQ + c * 64 + 32, g, lane);
    float xr = 0.f, xi = 0.f;
    { const int gi = (l * NGRP + g) * NST + lane; const float alr = tab[TAB_AL + 2 * gi], ali = tab[TAB_AL + 2 * gi + 1];
      const GAS f32x2* ep = (const GAS f32x2*)(SE + ((size_t)(bg * 64) * NST + lane) * 2); float pr = 1.f, pi = 0.f;
      for (int bt = 0; bt < 2; ++bt) { if (bt * 32 < c) {
        f32x2 e[32];
#pragma unroll
        for (int j = 0; j < 32; ++j) { const int cc = c - 1 - (bt * 32 + j); e[j] = ep[(size_t)(cc > 0 ? cc : 0) * NST]; if (cc < 0) e[j] = (f32x2){0.f, 0.f}; }
#pragma unroll
        for (int j = 0; j < 32; ++j) { xr += pr * e[j][0] - pi * e[j][1]; xi += pr * e[j][1] + pi * e[j][0]; const float nr = pr * alr - pi * ali, ni = pr * ali + pi * alr; pr = nr; pi = ni; } } } }
    float x0r = __shfl(xr, c32), x0i = __shfl(xi, c32), x1r = __shfl(xr, 32 + c32), x1i = __shfl(xi, 32 + c32);
    const float dsk = A->in[I_SSM_D][l * SSMW + g * 16 + t16];
#pragma unroll 1
    for (int rb = 0; rb < 2; ++rb) {
        const size_t tok0 = (size_t)b * SEQ + c * 64 + rb * 32;
        f32x16s acc[4]; ssm_bu32(acc, Bf, rb ? u1 : u0);
#pragma unroll
        for (int ph = 0; ph < 2; ++ph) {
            if (ph == 1) { x0r = __shfl(x0r, c32); x0i = __shfl(x0i, c32); x1r = __shfl(x1r, c32); x1i = __shfl(x1i, c32); }
#pragma unroll
            for (int r = 0; r < 16; ++r) { const float n0r = Bf.ar0 * x0r - Bf.ai0 * x0i + acc[0][r], n0i = Bf.ar0 * x0i + Bf.ai0 * x0r + acc[1][r]; x0r = n0r; x0i = n0i;
                const float n1r = Bf.ar1 * x1r - Bf.ai1 * x1i + acc[2][r], n1i = Bf.ar1 * x1i + Bf.ai1 * x1r + acc[3][r]; x1r = n1r; x1i = n1i;
                const int row = (hi == ph) ? (16 * ph + r) : 32;
                *(LAS unsigned*)(xs + row * 272 + 4 * c32) = cvtpk(x0r, x0i); *(LAS unsigned*)(xs + row * 272 + 4 * (32 + c32)) = cvtpk(x1r, x1i); }
        }
        x0r = __shfl(x0r, 32 + c32); x0i = __shfl(x0i, 32 + c32); x1r = __shfl(x1r, 32 + c32); x1i = __shfl(x1i, 32 + c32);
        LDS_WAIT(); asm volatile("" ::: "memory");
#pragma unroll
        for (int tt = 0; tt < 2; ++tt) {
            f32x4 y = {0.f, 0.f, 0.f, 0.f};
#pragma unroll
            for (int s4 = 0; s4 < 4; ++s4) { const bf16x8 xa = *(const LAS bf16x8*)(xs + (16 * tt + t16) * 272 + (32 * s4 + 8 * kk) * 2);
                y = __builtin_amdgcn_mfma_f32_16x16x32_bf16(xa, Cl[s4], y, 0, 0, 0); y = __builtin_amdgcn_mfma_f32_16x16x32_bf16(xa, Ch[s4], y, 0, 0, 0); asm volatile("" :: "v"(xa)); }
#pragma unroll
            for (int r = 0; r < 4; ++r) { const size_t tok = tok0 + 16 * tt + 4 * kk + r; const float z = gelu_tanh(y[r] + dsk * UA[tok * SSMW + g * 16 + t16]);
                Z[tok * SSMW + g * 16 + t16] = (bf16)(cvtpk(z, z) & 0xffffu); }
        }
        LDS_WAIT(); asm volatile("" ::: "memory");
    }
}

namespace att {
using f32x16 = __attribute__((ext_vector_type(16))) float;
using s16x4 = __attribute__((ext_vector_type(4))) short;
#define KSWZ(row, colB) ((row) * 256 + ((colB) ^ (((row) & 7) << 4)))
#define SBAR() __builtin_amdgcn_sched_barrier(0)
__device__ __forceinline__ int crow(int r, int hi) { return (r & 3) + 8 * (r >> 2) + 4 * hi; }
__device__ __forceinline__ void qkt(f32x16& p0, f32x16& p1, const LAS char* Ks, const bf16x8* qr, int r32, int hi) {
    bf16x8 fa, fb;
    { const int cb = (hi * 8) * 2; fa = *(const LAS bf16x8*)(Ks + KSWZ(r32, cb)); fb = *(const LAS bf16x8*)(Ks + KSWZ(32 + r32, cb)); }
#pragma unroll
    for (int d0 = 0; d0 < 8; ++d0) {
        const bf16x8 b0 = fa, b1 = fb;
        if (d0 + 1 < 8) { const int cb = ((d0 + 1) * 16 + hi * 8) * 2; fa = *(const LAS bf16x8*)(Ks + KSWZ(r32, cb)); fb = *(const LAS bf16x8*)(Ks + KSWZ(32 + r32, cb)); }
        p0 = __builtin_amdgcn_mfma_f32_32x32x16_bf16(b0, qr[d0], p0, 0, 0, 0); p1 = __builtin_amdgcn_mfma_f32_32x32x16_bf16(b1, qr[d0], p1, 0, 0, 0);
        SBAR();
    }
}
__device__ __forceinline__ int v_st(int k, int c) { const int kk = (k & ~0xC) | ((k & 4) << 1) | ((k & 8) >> 1); return ((kk >> 3) * 4 + (c >> 5)) * 512 + ((kk & 7) * 32 + (c & 31)) * 2; }
__device__ __forceinline__ int v_rd_base(int lane) { return ((lane & 3) << 3) | (((lane >> 2) & 3) << 6) | (((lane >> 4) & 1) << 5) | (((lane >> 5) & 1) << 8); }
constexpr int v_rd_off(int d0, int ks, int half) { return d0 * 512 + ks * 4096 + half * 2048; }
template <int OFF> __device__ __forceinline__ s16x4 tr_read(int vb) { s16x4 r; asm volatile("ds_read_b64_tr_b16 %0, %1 offset:%2" : "=&v"(r) : "v"(vb), "i"(OFF) : "memory"); return r; }
template <int D0> __device__ __forceinline__ void pv_one(f32x16& od, int vb, bf16x8 pa0, bf16x8 pa1, bf16x8 pa2, bf16x8 pa3) {
    const s16x4 l0 = tr_read<v_rd_off(D0, 0, 0)>(vb), h0 = tr_read<v_rd_off(D0, 0, 1)>(vb), l1 = tr_read<v_rd_off(D0, 1, 0)>(vb), h1 = tr_read<v_rd_off(D0, 1, 1)>(vb);
    const s16x4 l2 = tr_read<v_rd_off(D0, 2, 0)>(vb), h2 = tr_read<v_rd_off(D0, 2, 1)>(vb), l3 = tr_read<v_rd_off(D0, 3, 0)>(vb), h3 = tr_read<v_rd_off(D0, 3, 1)>(vb);
    asm volatile("s_waitcnt lgkmcnt(0)" ::: "memory"); SBAR();
#define PK(L, H) (bf16x8){L[0], L[1], L[2], L[3], H[0], H[1], H[2], H[3]}
    od = __builtin_amdgcn_mfma_f32_32x32x16_bf16(pa0, PK(l0, h0), od, 0, 0, 0);
    od = __builtin_amdgcn_mfma_f32_32x32x16_bf16(pa1, PK(l1, h1), od, 0, 0, 0);
    od = __builtin_amdgcn_mfma_f32_32x32x16_bf16(pa2, PK(l2, h2), od, 0, 0, 0);
    od = __builtin_amdgcn_mfma_f32_32x32x16_bf16(pa3, PK(l3, h3), od, 0, 0, 0);
#undef PK
}
template <int NV>
__device__ __forceinline__ void tile_step(f32x16& p0, f32x16& p1, f32x16 (&o)[NV], float& m_reg, float& l_reg, const LAS char* Ks, int vb, const bf16x8* qr, LAS float* al, int r32, int hi) {
    qkt(p0, p1, Ks, qr, r32, hi);
    float pmax = p0[0];
#pragma unroll
    for (int r = 1; r < 16; ++r) pmax = fmaxf(pmax, p0[r]);
#pragma unroll
    for (int r = 0; r < 16; ++r) pmax = fmaxf(pmax, p1[r]);
    { auto rr = __builtin_amdgcn_permlane32_swap(__float_as_uint(pmax), __float_as_uint(pmax), false, false); pmax = fmaxf(__uint_as_float(rr[0]), __uint_as_float(rr[1])); }
    const float mn = fmaxf(m_reg, pmax), alpha = __builtin_amdgcn_exp2f(m_reg - mn); m_reg = mn;
    float ps = 0.f;
#pragma unroll
    for (int r = 0; r < 16; ++r) { p0[r] = __builtin_amdgcn_exp2f(p0[r] - mn); ps += p0[r]; }
#pragma unroll
    for (int r = 0; r < 16; ++r) { p1[r] = __builtin_amdgcn_exp2f(p1[r] - mn); ps += p1[r]; }
    { auto rr = __builtin_amdgcn_permlane32_swap(__float_as_uint(ps), __float_as_uint(ps), false, false); ps = __uint_as_float(rr[0]) + __uint_as_float(rr[1]); }
    l_reg = l_reg * alpha + ps;
    if (__any(alpha < 1.f)) { if (hi == 0) al[r32] = alpha; asm volatile("s_waitcnt lgkmcnt(0)" ::: "memory");
#pragma unroll
        for (int d = 0; d < NV; ++d)
#pragma unroll
            for (int r = 0; r < 16; ++r) o[d][r] *= al[crow(r, hi)]; }
    bf16x8 pa0, pa1, pa2, pa3;
#define PK4(P, BASE, OUT) do { unsigned a0 = cvtpk(P[BASE + 0], P[BASE + 1]), a1 = cvtpk(P[BASE + 2], P[BASE + 3]); unsigned b0 = cvtpk(P[BASE + 4], P[BASE + 5]), b1 = cvtpk(P[BASE + 6], P[BASE + 7]); \
    auto r0 = __builtin_amdgcn_permlane32_swap(a0, b0, false, false); auto r1 = __builtin_amdgcn_permlane32_swap(a1, b1, false, false); v4u w = {r0[0], r1[0], r0[1], r1[1]}; OUT = *reinterpret_cast<bf16x8*>(&w); } while (0)
    PK4(p0, 0, pa0); PK4(p0, 8, pa1); PK4(p1, 0, pa2); PK4(p1, 8, pa3);
#undef PK4
    SBAR();
    pv_one<0>(o[0], vb, pa0, pa1, pa2, pa3); pv_one<1>(o[1], vb, pa0, pa1, pa2, pa3); pv_one<2>(o[2], vb, pa0, pa1, pa2, pa3); pv_one<3>(o[3], vb, pa0, pa1, pa2, pa3);
    if constexpr (NV == 8) { pv_one<32>(o[4], vb, pa0, pa1, pa2, pa3); pv_one<33>(o[5], vb, pa0, pa1, pa2, pa3); pv_one<34>(o[6], vb, pa0, pa1, pa2, pa3); pv_one<35>(o[7], vb, pa0, pa1, pa2, pa3); }
}

constexpr int BAND_UNITS = NB * CA_H * (SEQ / 256);
constexpr int ATT_AL_OFF = 132096;
__device__ __forceinline__ void band_unit(const Frame& F, KArgs A, int l, int un) {
    int tid_ = fresh_tid(); asm volatile("" : "+v"(tid_)); const int tid = tid_, lane = tid & 63, r32 = lane & 31, hi = lane >> 5, wid = F.wave;
    const int qb = 15 - un / (NB * CA_H), rem = un % (NB * CA_H), b = rem / CA_H, h = rem % CA_H;
    const bf16* QKV = (const bf16*)(A->ws + WS_QKV); bf16* YB = (bf16*)(A->ws + WS_YB);
    LAS char* Kb = (LAS char*)(F.lds + RING_OFF);
    LAS float* bt = (LAS float*)(F.lds + RING_OFF + 65536); LAS float* al = (LAS float*)(F.lds + ATT_AL_OFF) + wid * 64;
    const size_t rowb = (size_t)b * SEQ;
    { const float* rb = A->in[I_CA_BIAS] + (size_t)(l * CA_H + h) * 257;
      for (int i = tid; i < 640; i += 512) { int rel = i - 63; rel = rel > 128 ? 128 : rel; bt[i] = rb[rel + 128] * LOG2E; } }
    bf16x8 qr[8];
    { const bf16* Qw = QKV + (rowb + qb * 256 + wid * 32 + r32) * QKVW + h * HD + hi * 8;
#pragma unroll
      for (int d0 = 0; d0 < 8; ++d0) qr[d0] = *(const GAS bf16x8*)(Qw + d0 * 16); }
    const int t_lo = (4 * qb - 8) > 0 ? (4 * qb - 8) : 0, t_hi = 4 * qb + 3, cw = 4 * qb + (wid >> 1);
    const int vb0 = (int)(uintptr_t)(Kb + 16384) + v_rd_base(lane);
    const int img = wid >> 2, part = wid & 3;
    unsigned voff[2];
    { const int row8 = (lane >> 2) & 7;
      const unsigned vl = (unsigned)((8 * (row8 >> 2) + (row8 & 3)) * QKVW * 2 + (hi * 32 + (lane & 3) * 8) * 2);
#pragma unroll
      for (int i1 = 0; i1 < 2; ++i1) voff[i1] = img == 0 ? (unsigned)((lane >> 4) * QKVW * 2 + ((lane & 15) ^ (i1 * 4 + (lane >> 4))) * 16) : vl; }
    const char* gsrc = (const char*)(QKV + rowb * QKVW + (img == 0 ? 1536 : 3072) + h * HD) + (size_t)(part * 16) * QKVW * 2;
    LAS unsigned char* dst0 = (LAS unsigned char*)Kb + img * 16384 + part * 4096;
#define DMAT(t, bo) do { const char* gs_ = gsrc + (size_t)(t) * 64 * QKVW * 2; _Pragma("unroll") for (int i_ = 0; i_ < 4; ++i_) { \
        const size_t ub_ = img == 0 ? (size_t)(4 * i_) * QKVW * 2 : (size_t)(((i_ >> 1) & 1) * 4) * QKVW * 2 + (i_ & 1) * 128; \
        __builtin_amdgcn_global_load_lds((const unsigned*)(gs_ + ub_ + voff[i_ & 1]), (LAS unsigned*)(dst0 + (bo) + i_ * 1024), 16, 0, 0); } } while (0)
    DMAT(t_lo, 0);
    float m_reg = -1e30f, l_reg = 0.f; f32x16 o[4] = {};
    asm volatile("s_waitcnt vmcnt(0)" ::: "memory"); __syncthreads();
    for (int t = t_lo; t <= t_hi; ++t) {
        const int cur = ((t - t_lo) & 1) * 32768;
        if (t < t_hi) DMAT(t + 1, cur ^ 32768);
        if (t >= cw - 8 && t <= cw) {
            const int base = qb * 256 + wid * 32 + r32 + 63 - 4 * hi - 64 * t;
            f32x16 p0, p1;
#pragma unroll
            for (int r = 0; r < 16; ++r) { const int cr = (r & 3) + 8 * (r >> 2); p0[r] = bt[base - cr]; p1[r] = bt[base - cr - 32]; }
            tile_step<4>(p0, p1, o, m_reg, l_reg, Kb + cur, vb0 + cur, qr, al, r32, hi);
        }
        asm volatile("s_waitcnt vmcnt(0)" ::: "memory"); __syncthreads();
    }
#undef DMAT
    if (hi == 0) al[r32] = l_reg; asm volatile("s_waitcnt lgkmcnt(0)" ::: "memory");
    bf16* Ow = YB + (rowb + qb * 256 + wid * 32) * CAW + h * HD;
#pragma unroll
    for (int r = 0; r < 16; ++r) { const int orow = crow(r, hi); const float rl = __builtin_amdgcn_rcpf(al[orow]);
#pragma unroll
        for (int d0 = 0; d0 < 4; ++d0) Ow[(size_t)orow * CAW + d0 * 32 + r32] = (bf16)(cvtpk(o[d0][r] * rl, 0.f) & 0xffffu); }
}

constexpr int DIFF_UNITS = NB * DA_H * (SEQ / 128);
__device__ __forceinline__ void diff_unit(const Frame& F, KArgs A, int l, int un) {
    int tid_ = fresh_tid(); asm volatile("" : "+v"(tid_)); const int tid = tid_, lane = tid & 63, r32 = lane & 31, hi = lane >> 5, wid = F.wave;
    const int jb = 31 - un / (NB * DA_H), rem = un % (NB * DA_H), b = rem / DA_H, h = rem % DA_H;
    const int rg = wid & 3, mp = wid >> 2, cw = 2 * jb + (rg >> 1), t_hi = 2 * jb + 1;
    const bf16* QKV = (const bf16*)(A->ws + WS_QKV); bf16* YC = (bf16*)(A->ws + WS_YC);
    LAS char* Kb = (LAS char*)(F.lds + RING_OFF);
    LAS float* al = (LAS float*)(F.lds + ATT_AL_OFF) + wid * 64;
    const size_t rowb = (size_t)b * SEQ;
    const float slope2 = exp2f(-8.0f * (float)(h + 1) / (float)DA_H) * LOG2E;
    bf16x8 qr[8];
    { const bf16* Qw = QKV + (rowb + jb * 128 + rg * 32 + r32) * QKVW + 4608 + h * 256 + mp * HD + hi * 8;
#pragma unroll
      for (int d0 = 0; d0 < 8; ++d0) qr[d0] = *(const GAS bf16x8*)(Qw + d0 * 16); }
    const LAS char* Ks = Kb + mp * 16384; const int vb0 = (int)(uintptr_t)(Kb + 32768) + v_rd_base(lane);
    const int img = wid >> 1, part = wid & 1;
    unsigned voff[2];
    { const int row8 = (lane >> 2) & 7;
      const unsigned vl = (unsigned)((8 * (row8 >> 2) + (row8 & 3)) * QKVW * 2 + (hi * 32 + (lane & 3) * 8) * 2);
#pragma unroll
      for (int i1 = 0; i1 < 2; ++i1) voff[i1] = img < 2 ? (unsigned)((lane >> 4) * QKVW * 2 + ((lane & 15) ^ (i1 * 4 + (lane >> 4))) * 16) : vl; }
    const char* gsrc = (const char*)(QKV + rowb * QKVW + (img < 2 ? 6144 : 7680) + h * 256 + (img & 1) * 128) + (size_t)(part * 32) * QKVW * 2;
    LAS unsigned char* dst0 = (LAS unsigned char*)Kb + img * 16384 + part * 8192;
#define DMAT(t, bo) do { const char* gs_ = gsrc + (size_t)(t) * 64 * QKVW * 2; _Pragma("unroll") for (int i_ = 0; i_ < 8; ++i_) { \
        const size_t ub_ = img < 2 ? (size_t)(4 * i_) * QKVW * 2 : (size_t)((i_ >> 2) * 16 + ((i_ >> 1) & 1) * 4) * QKVW * 2 + (i_ & 1) * 128; \
        __builtin_amdgcn_global_load_lds((const unsigned*)(gs_ + ub_ + voff[i_ & 1]), (LAS unsigned*)(dst0 + (bo) + i_ * 1024), 16, 0, 0); } } while (0)
    DMAT(t_hi, 0);
    float m_reg = -1e30f, l_reg = 0.f; f32x16 o[8] = {};
    asm volatile("s_waitcnt vmcnt(0)" ::: "memory"); __syncthreads();
    for (int st = 0; st <= t_hi; ++st) {
        const int t = t_hi - st, cur = (st & 1) * 65536;
        if (t > 0) DMAT(t - 1, cur ^ 65536);
        if (t <= cw) {
            const float basef = (float)(64 * (cw - t) + (rg & 1) * 32 + r32 - 4 * hi);
            f32x16 p0, p1;
            if (t == cw) {
#pragma unroll
                for (int r = 0; r < 16; ++r) { const float cr = (float)((r & 3) + 8 * (r >> 2)); p0[r] = -slope2 * fabsf(basef - cr); p1[r] = -slope2 * fabsf(basef - cr - 32.f); }
            } else {
                const float nb = -slope2 * basef;
#pragma unroll
                for (int r = 0; r < 16; ++r) { const float cr = (float)((r & 3) + 8 * (r >> 2)); p0[r] = fmaf(slope2, cr, nb); p1[r] = fmaf(slope2, cr + 32.f, nb); }
            }
            tile_step<8>(p0, p1, o, m_reg, l_reg, Ks + cur, vb0 + cur, qr, al, r32, hi);
        }
        asm volatile("s_waitcnt vmcnt(0)" ::: "memory"); __syncthreads();
    }
#undef DMAT
    if (hi == 0) al[r32] = l_reg; asm volatile("s_waitcnt lgkmcnt(0)" ::: "memory");
#pragma unroll
    for (int r = 0; r < 16; ++r) { const float rl = __builtin_amdgcn_rcpf(al[crow(r, hi)]);
#pragma unroll
        for (int d0 = 0; d0 < 8; ++d0) o[d0][r] *= rl; }
    LAS float* X = (LAS float*)(F.lds + RING_OFF) + rg * (32 * 132);
    const float lam = ((const float*)(A->ws + WS_TAB))[TAB_LAM + l];
    const int erow = lane >> 1, eh = lane & 1;
    f32x4 val[2][16]; float sq = 0.f;
#pragma unroll
    for (int hf = 0; hf < 2; ++hf) {
        if (mp == 1) {
#pragma unroll
            for (int r = 0; r < 16; ++r)
#pragma unroll
                for (int d0 = 0; d0 < 4; ++d0) X[crow(r, hi) * 132 + d0 * 32 + r32] = o[4 * hf + d0][r];
        }
        __syncthreads();
        if (mp == 0) {
#pragma unroll
            for (int r = 0; r < 16; ++r)
#pragma unroll
                for (int d0 = 0; d0 < 4; ++d0) { LAS float* xp = X + crow(r, hi) * 132 + d0 * 32 + r32; *xp = o[4 * hf + d0][r] - lam * *xp; }
            asm volatile("s_waitcnt lgkmcnt(0)" ::: "memory");
#pragma unroll
            for (int j = 0; j < 16; ++j) { val[hf][j] = *(const LAS f32x4*)(X + erow * 132 + eh * 64 + 4 * j); sq += (val[hf][j][0] * val[hf][j][0] + val[hf][j][1] * val[hf][j][1]) + (val[hf][j][2] * val[hf][j][2] + val[hf][j][3] * val[hf][j][3]); }
        }
        __syncthreads();
    }
    if (mp == 0) {
        sq += __shfl_xor(sq, 1);
        int ll = l; asm volatile("" : "+s"(ll));
        const float rr = rsqrtf(sq * (1.0f / 256.0f) + EPS) * (1.0f - lambda_init_of(ll));
#pragma unroll
        for (int hf = 0; hf < 2; ++hf) {
            const float* gn = A->in[I_SUBLN] + l * 256 + hf * 128 + eh * 64;
            bf16* op = YC + (rowb + jb * 128 + rg * 32 + erow) * DAW + h * 256 + hf * 128 + eh * 64;
#pragma unroll
            for (int j = 0; j < 16; j += 2) { const f32x4 g0 = *(const f32x4*)(gn + 4 * j), g1 = *(const f32x4*)(gn + 4 * j + 4);
                v4u w; w.x = cvtpk(val[hf][j][0] * rr * g0[0], val[hf][j][1] * rr * g0[1]); w.y = cvtpk(val[hf][j][2] * rr * g0[2], val[hf][j][3] * rr * g0[3]);
                w.z = cvtpk(val[hf][j + 1][0] * rr * g1[0], val[hf][j + 1][1] * rr * g1[1]); w.w = cvtpk(val[hf][j + 1][2] * rr * g1[2], val[hf][j + 1][3] * rr * g1[3]);
                *(GAS v4u*)(op + 4 * j) = w; }
        }
    }
}
#undef KSWZ
#undef SBAR
}

__global__ void __launch_bounds__(NWAVES * 64, 2) mk_fwd(Args args) {
    extern __shared__ __attribute__((aligned(16))) unsigned char lds[];
    Frame F;
    F.lds = (LAS unsigned char*)lds;
    F.MISC = (volatile LAS unsigned*)(F.lds + MISC_OFF);
    F.wave = __builtin_amdgcn_readfirstlane(fresh_tid() >> 6);
    F.G = gridDim.x; F.in = nullptr; F.ws = args.ws;
    unsigned char* ws = args.ws;
    F.ctl = (gu32*)(ws + WS_CTL);
    for (int u = fresh_tid(); u < (LDS_BYTES - LDSCTL_OFF) / 4; u += NWAVES * 64) ((LAS unsigned*)(F.lds + LDSCTL_OFF))[u] = 0u;
    __syncthreads();
    XcdBarrier bar; bar.bar = (unsigned*)(F.ctl + CW_BAR); bar.x = 0; bar.st = nullptr;
    if (N_LAUNCHES == 1) bar = xcd_barrier_post((unsigned*)(F.ctl + CW_BAR), F.MISC + 8);
#define GRID_BAR() do { if (N_LAUNCHES != 1) { if (fresh_tid() == 0) __hip_atomic_store(F.ctl + CW_TMO, 0xBADBA0u, RLX_AGENT); } else { xcd_barrier(bar); } } while (0)
    const KArgs kap = (KArgs)__builtin_amdgcn_kernarg_segment_ptr();
#define LARGS(name) KArgs name##_p = kap; asm volatile("" : "+s"(name##_p)); KArgs name = name##_p
    const int lo = args.ph_lo, hi = args.ph_hi;
#define IN(k) (lo <= (k) && (k) < hi)
#define BOTH(k) (IN(k) && IN((k) + 1))

    if (IN(0)) { LARGS(A0); p0_prologue(F, A0); if (BOTH(0)) GRID_BAR(); }

    for (int l = 0; l < NL; ++l) {
        const int pb = 1 + 8 * l;
#define PHASE_ENV() LARGS(A); int lp = l; asm volatile("" : "+s"(lp)); int bx = (int)blockIdx.x; asm volatile("" : "+s"(bx)); (void)bx; unsigned char* ws = A->ws; unsigned char* wl = ws + WS_WT + (size_t)lp * WT_LAYER; \
        float* ssb = (float*)(ws + WS_SSP); float* ss_in = ssb + (size_t)lp * M * 64; float* ss_mid = ssb + (size_t)(NL + lp) * M * 64; float* ss_next = (lp + 1 < NL) ? ssb + (size_t)(lp + 1) * M * 64 : nullptr; \
        pg8::bf16_t* XB = (pg8::bf16_t*)(ws + WS_XB); float* X1 = (float*)(ws + WS_X1); (void)wl; (void)ss_in; (void)ss_mid; (void)ss_next; (void)XB; (void)X1

#define ROW_SCALES(ssp_, S_) pg8::Unit u0_; u0_.pm = 0; u0_.pn = 0; (void)(S_).next(0, u0_); { LAS float* rt_ = (LAS float*)(F.lds + EPI_TAB_OFF); const int t_ = fresh_tid(); \
            if (t_ < 256) rt_[t_] = pg8::rms_from_slots(ssp_, u0_.pm * 256 + t_); \
            rt_[2304 + t_] = ((const float*)(ws + WS_TAB))[TAB_G + lp * 512 + t_];   } LDS_WAIT(); __syncthreads(); \
        const pg8::RowScale rs_{ssp_, (const LAS float*)(F.lds + EPI_TAB_OFF), u0_.pm}
        if (IN(pb + 0)) {
            PHASE_ENV();
            pg8::Gemm g{XB, (const pg8::bf16_t*)(wl + WT_IN), M, NQ, DM}; pg8::InterleavedOrder S; S.init(M, NQ, F.G, bx);
            ROW_SCALES(ss_in, S);
            (void)rs_; pg8::EpiIn E{ws, F.lds + EPI_TAB_OFF, lp};
            pg8::gemm_phase<pg8::EpiIn, pg8::InterleavedOrder, true, true>(F.lds + RING_OFF, g, S, E);
            pg8::Gemm g8{(const pg8::bf16_t*)(ws + WS_XB8), (const pg8::bf16_t*)(wl + WT_IN + WT_G8), M, NGATE, DM / 2}; pg8::StaticOrder S8; S8.init(M, NGATE, F.G, bx);
            pg8::EpiGate E8{(const LAS float*)(F.lds + EPI_TAB_OFF), ws + WS_GT, 1.0f / GATE_WSCALE};
            pg8::gemm_phase<pg8::EpiGate, pg8::StaticOrder, true, true, true>(F.lds + RING_OFF, g8, S8, E8);
            if (BOTH(pb + 0)) GRID_BAR();
        }
        if (IN(pb + 1)) {
            PHASE_ENV();
            ssm_stage_a(F, A, lp);
            if (BOTH(pb + 1)) GRID_BAR();
        }
        if (IN(pb + 2)) {
            PHASE_ENV();
            gu32* qh = F.ctl + CW_Q + 64 * (lp * 4);
            const int nconv = CONV_REST + ((lp + 1 < NL) ? CONV_WIN : 0);
#ifndef CONV_MASK
#define CONV_MASK 1
#endif
            if (((bx >> 3) & CONV_MASK) == 0) for (;;) { const int c = q_pop(F, qh + 192); if (c >= nconv) break; conv_chunk(F, A, lp, c); }
            for (;;) { const int un = q_pop(F, qh); if (un >= att::DIFF_UNITS) break; att::diff_unit(F, A, lp, un); }
            for (;;) { const int un = q_pop(F, qh + 64); if (un >= att::BAND_UNITS) break; att::band_unit(F, A, lp, un); }
            for (;;) { const int un = q_pop(F, qh + 128); if (un >= SSM_UNITS) break; ssm_stage_c(F, A, lp, un); }
            for (;;) { const int c = q_pop(F, qh + 192); if (c >= nconv) break; conv_chunk(F, A, lp, c); }
            if (BOTH(pb + 2)) GRID_BAR();
        }
        if (IN(pb + 3)) {
            PHASE_ENV();
            pg8::Gemm g{(const pg8::bf16_t*)(ws + WS_Z), (const pg8::bf16_t*)(wl + WT_GLU), M, SSMW, SSMW}; pg8::StaticOrder S; S.init(M, SSMW, F.G, bx);
            pg8::EpiGlu E{(const pg8::bf16_t*)(ws + WS_Z), A->in[I_B_GLU] + lp * SSMW, (pg8::bf16_t*)(ws + WS_YA)};
            pg8::gemm_phase<pg8::EpiGlu, pg8::StaticOrder, true, true>(F.lds + RING_OFF, g, S, E);
            if (BOTH(pb + 3)) GRID_BAR();
        }
        if (IN(pb + 4)) {
            PHASE_ENV();
            const unsigned char* GT = ws + WS_GT; pg8::bf16_t* MF = (pg8::bf16_t*)(ws + WS_MF); pg8::bf16_t* MB = (pg8::bf16_t*)(ws + WS_MB);
            pg8::StaticOrder S; S.init(M, DM, F.G, bx);
            { pg8::Gemm g{(const pg8::bf16_t*)(ws + WS_YA), (const pg8::bf16_t*)(wl + WT_OA), M, DM, SSMW}; pg8::EpiMerge<0> E{GT, 0, MF, MB};
              pg8::gemm_phase<pg8::EpiMerge<0>, pg8::StaticOrder, true, true>(F.lds + RING_OFF, g, S, E); }
            { pg8::Gemm g{(const pg8::bf16_t*)(ws + WS_YB), (const pg8::bf16_t*)(wl + WT_OB), M, DM, CAW}; pg8::EpiMerge<1> E{GT, DM, MF, MB};
              pg8::gemm_phase<pg8::EpiMerge<1>, pg8::StaticOrder, true, true>(F.lds + RING_OFF, g, S, E); }
            { pg8::Gemm g{(const pg8::bf16_t*)(ws + WS_YC), (const pg8::bf16_t*)(wl + WT_OC), M, DM, DAW}; pg8::EpiMerge<2> E{GT, 2 * DM, MF, MB};
              pg8::gemm_phase<pg8::EpiMerge<2>, pg8::StaticOrder, true, true>(F.lds + RING_OFF, g, S, E); }
            if (BOTH(pb + 4)) GRID_BAR();
        }
        if (IN(pb + 5)) {
            PHASE_ENV();
            pg8::Gemm g{(const pg8::bf16_t*)(ws + WS_MB), (const pg8::bf16_t*)(wl + WT_O), M, DM, DM}; pg8::StaticOrder S; S.init(M, DM, F.G, bx);
            const float* xin = (lp == 0) ? A->in[I_X] : (const float*)A->out;
            pg8::EpiRes E{xin, X1, XB, ss_mid, nullptr};
            pg8::gemm_phase<pg8::EpiRes, pg8::StaticOrder, true, true>(F.lds + RING_OFF, g, S, E);
            if (BOTH(pb + 5)) GRID_BAR();
        }
        if (IN(pb + 6)) {
            PHASE_ENV();
            pg8::Gemm g{XB, (const pg8::bf16_t*)(wl + WT_F1), M, DFF, DM}; pg8::StaticOrder S; S.init(M, DFF, F.G, bx);
            ROW_SCALES(ss_mid, S);
            pg8::EpiFf1 E{rs_, (pg8::bf16_t*)(ws + WS_H)};
            pg8::gemm_phase<pg8::EpiFf1, pg8::StaticOrder, true, true>(F.lds + RING_OFF, g, S, E);
            if (BOTH(pb + 6)) GRID_BAR();
        }
        if (IN(pb + 7)) {
            PHASE_ENV();
            pg8::Gemm g{(const pg8::bf16_t*)(ws + WS_H), (const pg8::bf16_t*)(wl + WT_F2), M, DM, DFF}; pg8::StaticOrder S; S.init(M, DM, F.G, bx);
            pg8::EpiRes E{X1, A->out, (lp + 1 < NL) ? XB : nullptr, ss_next, (lp + 1 < NL) ? ws + WS_XB8 : nullptr};
            pg8::gemm_phase<pg8::EpiRes, pg8::StaticOrder, true, true>(F.lds + RING_OFF, g, S, E);
            if (BOTH(pb + 7)) GRID_BAR();
        }
    }
#undef IN
#undef BOTH
}

extern "C" void kernel_launch(void* const* d_in, const int* in_sizes, int n_in, void* d_out, int out_size, void* d_ws, size_t ws_size, hipStream_t stream) {
    static int grid = 0;
    if (grid == 0) {
        if (n_in != 30 || in_sizes[0] != M * DM || out_size != M * DM || ws_size < WS_END) {
            fprintf(stderr, "kernel_launch: built for 30 inputs, x/out of %d floats, >= %zu bytes of workspace; got n_in %d, in0 %d, out %d, ws %zu; nothing launched\n", M * DM, (size_t)WS_END, n_in, n_in > 0 ? in_sizes[0] : -1, out_size, ws_size);
            grid = -1; return; }
        int dev = 0, cus = 0, per_cu = 0;
        if (hipGetDevice(&dev) != hipSuccess || hipDeviceGetAttribute(&cus, hipDeviceAttributeMultiprocessorCount, dev) != hipSuccess) { fprintf(stderr, "kernel_launch: device query failed\n"); grid = -1; return; }
        if (hipFuncSetAttribute((const void*)mk_fwd, hipFuncAttributeMaxDynamicSharedMemorySize, LDS_BYTES) != hipSuccess) { fprintf(stderr, "kernel_launch: hipFuncSetAttribute failed\n"); grid = -1; return; }
        if (hipOccupancyMaxActiveBlocksPerMultiprocessor(&per_cu, (const void*)mk_fwd, NWAVES * 64, LDS_BYTES) != hipSuccess || per_cu < 1)
            fprintf(stderr, "kernel_launch: note: occupancy query reports %d workgroups per CU\n", per_cu);
        (void)hipGetLastError();
        grid = cus;
        if (grid != 256) { fprintf(stderr, "kernel_launch: built for a 256-CU device (unit deal and row-panel tables assume 256 workgroups); found %d CUs; nothing launched\n", cus); grid = -1; return; }
    }
    if (grid < 0) return;
    if (hipMemsetAsync((char*)d_ws + WS_CTL, 0, CTL_ZERO_BYTES, stream) != hipSuccess) { fprintf(stderr, "kernel_launch: memset failed\n"); return; }
    Args a{};
    for (int i = 0; i < 30; ++i) a.in[i] = (const float*)d_in[i];
    a.out = (float*)d_out; a.ws = (unsigned char*)d_ws;
    for (int li = 0; li < N_LAUNCHES; ++li) {
        a.ph_lo = (N_LAUNCHES == 1) ? 0 : li; a.ph_hi = (N_LAUNCHES == 1) ? N_PHASES : li + 1; a.li = li; a.pad = 0;
        hipLaunchKernelGGL(mk_fwd, dim3(grid), dim3(NWAVES * 64), LDS_BYTES, stream, a);
        const hipError_t le = hipPeekAtLastError();
        if (le != hipSuccess) { fprintf(stderr, "kernel_launch: launch %d failed: %s\n", li, hipGetErrorName(le)); break; }
    }
}
```
